# Optimizing an MI355X kernel written in HIP

```python
import math
import jax, jax.numpy as jnp
from jax import lax
import numpy as np

D_MODEL = 1024
BATCH = 8
SEQ = 8192
DEPTH = 4
DEC_BATCH = 16
DEC_SEQ = 2048
PAST_LEN = 128

N_MEM = 256
Q_BLOCK = 128
EPS = 1e-6
N_MIXERS = 2
N_LAYERS_A = (DEPTH + 1) // 2
N_LAYERS_B = DEPTH // 2
MLA_HEADS = 8
MLA_Q_LORA = 384
MLA_KV_LORA = 256
MLA_NOPE = 64
MLA_ROPE = 32
MLA_QK = MLA_NOPE + MLA_ROPE
MLA_V = 64
ROPE_THETA = 10000.0
DIFF_HEADS = 8
DIFF_HD = 64
XA_HEADS = 4
XA_HD = D_MODEL // XA_HEADS
D_FF = 2816
CONV_W = 3

kernel_name = 'hybrid_mla_diffattn_convglu_encoder'


def _rmsnorm(x, g):
    x32 = x.astype(jnp.float32)
    y = x32 * lax.rsqrt(jnp.mean(x32 * x32, axis=-1, keepdims=True) + EPS)
    return (y * g.astype(jnp.float32)).astype(x.dtype)


def _sweep_query_blocks(fn, q):
    b, s = q.shape[:2]
    nb = s // Q_BLOCK
    qb = jnp.moveaxis(q.reshape((b, nb, Q_BLOCK) + q.shape[2:]), 1, 0)
    out = lax.map(lambda a: fn(a[0], a[1]), (qb, jnp.arange(nb)))
    out = jnp.moveaxis(out, 0, 1)
    return out.reshape((b, s) + out.shape[3:])


def _rope_tables(seq):
    inv = ROPE_THETA ** (-jnp.arange(0, MLA_ROPE, 2, dtype=jnp.float32) / MLA_ROPE)
    ang = jnp.arange(seq, dtype=jnp.float32)[:, None] * inv[None, :]
    ang = jnp.concatenate([ang, ang], axis=-1)
    return jnp.cos(ang), jnp.sin(ang)


def _apply_rope(x, cos, sin):
    x32 = x.astype(jnp.float32)
    half = MLA_ROPE // 2
    rot = jnp.concatenate([-x32[..., half:], x32[..., :half]], axis=-1)
    return (x32 * cos[None, :, None, :] + rot * sin[None, :, None, :]).astype(x.dtype)


def _alibi_slopes(n):
    return 2.0 ** (-8.0 * jnp.arange(1, n + 1, dtype=jnp.float32) / n)


def _mla(x, norm_g, w_down, q_lat_g, kv_lat_g, w_uq, w_ukv, q_g, k_g, w_o):
    b, s, _ = x.shape
    h = _rmsnorm(x, norm_g)
    down = h @ w_down
    c_q, c_kv, k_rope = jnp.split(down, [MLA_Q_LORA, MLA_Q_LORA + MLA_KV_LORA], axis=-1)
    c_q = _rmsnorm(c_q, q_lat_g)
    c_kv = _rmsnorm(c_kv, kv_lat_g)
    q = (c_q @ w_uq).reshape(b, s, MLA_HEADS, MLA_QK)
    kv = (c_kv @ w_ukv).reshape(b, s, MLA_HEADS, MLA_NOPE + MLA_V)
    k_nope, v = jnp.split(kv, [MLA_NOPE], axis=-1)
    k_rope = jnp.broadcast_to(k_rope[:, :, None, :], (b, s, MLA_HEADS, MLA_ROPE))
    k = jnp.concatenate([k_nope, k_rope], axis=-1)
    q = _rmsnorm(q, q_g)
    k = _rmsnorm(k, k_g)
    cos, sin = _rope_tables(s)
    q = jnp.concatenate([q[..., :MLA_NOPE], _apply_rope(q[..., MLA_NOPE:], cos, sin)], axis=-1)
    k = jnp.concatenate([k[..., :MLA_NOPE], _apply_rope(k[..., MLA_NOPE:], cos, sin)], axis=-1)
    scale = MLA_QK ** -0.5

    def block(qb, bi):
        sc = jnp.einsum('bqhd,bkhd->bhqk', qb, k).astype(jnp.float32) * scale
        p = jax.nn.softmax(sc, axis=-1).astype(v.dtype)
        return jnp.einsum('bhqk,bkhe->bqhe', p, v)

    o = _sweep_query_blocks(block, q)
    return o.reshape(b, s, MLA_HEADS * MLA_V) @ w_o


def _diff_attn(x, layer_idx, norm_g, w_qkv, q_g, k_g, lam_p, sub_g, w_o):
    b, s, _ = x.shape
    lambda_init = 0.8 - 0.6 * math.exp(-0.3 * layer_idx)
    h = _rmsnorm(x, norm_g)
    q, k, v = jnp.split(h @ w_qkv, 3, axis=-1)
    q = _rmsnorm(q.reshape(b, s, DIFF_HEADS, 2, DIFF_HD), q_g)
    k = _rmsnorm(k.reshape(b, s, DIFF_HEADS, 2, DIFF_HD), k_g)
    v = v.reshape(b, s, DIFF_HEADS, 2 * DIFF_HD)
    lp = lam_p.astype(jnp.float32)
    lam = jnp.exp(jnp.sum(lp[0] * lp[1])) - jnp.exp(jnp.sum(lp[2] * lp[3])) + lambda_init
    slopes = _alibi_slopes(DIFF_HEADS)
    tk = jnp.arange(s)
    scale = DIFF_HD ** -0.5

    def block(qb, bi):
        tq = bi * Q_BLOCK + jnp.arange(Q_BLOCK)
        dist = jnp.abs(tq[:, None] - tk[None, :]).astype(jnp.float32)
        bias = -slopes[:, None, None] * dist[None]
        sc = jnp.einsum('bqhcd,bkhcd->bchqk', qb, k).astype(jnp.float32) * scale + bias
        p = jax.nn.softmax(sc, axis=-1)
        a = (p[:, 0] - lam * p[:, 1]).astype(v.dtype)
        return jnp.einsum('bhqk,bkhe->bqhe', a, v)

    o = _sweep_query_blocks(block, q)
    o = _rmsnorm(o, sub_g) * (1.0 - lambda_init)
    return o.reshape(b, s, DIFF_HEADS * 2 * DIFF_HD) @ w_o


def _mem_xattn(x, mem, norm_g, mem_g, w_q, w_kv, q_g, k_g, w_o):
    b, s, _ = x.shape
    m = mem.shape[1]
    q = (_rmsnorm(x, norm_g) @ w_q).reshape(b, s, XA_HEADS, XA_HD)
    k, v = jnp.split(_rmsnorm(mem, mem_g) @ w_kv, 2, axis=-1)
    k = k.reshape(b, m, XA_HEADS, XA_HD)
    v = v.reshape(b, m, XA_HEADS, XA_HD)
    q = _rmsnorm(q, q_g)
    k = _rmsnorm(k, k_g)
    sc = jnp.einsum('bqhd,bmhd->bhqm', q, k).astype(jnp.float32) * (XA_HD ** -0.5)
    p = jax.nn.softmax(sc, axis=-1).astype(v.dtype)
    o = jnp.einsum('bhqm,bmhd->bqhd', p, v).reshape(b, s, XA_HEADS * XA_HD)
    return o @ w_o


def _conv_glu(x, norm_g, w_gu, conv_w, conv_b, w_down):
    s = x.shape[1]
    h = _rmsnorm(x, norm_g)
    g, u = jnp.split(h @ w_gu, 2, axis=-1)
    pad = CONV_W // 2
    gp = jnp.pad(g, ((0, 0), (pad, pad), (0, 0)))
    g = sum(gp[:, j:j + s] * conv_w[j] for j in range(CONV_W)) + conv_b
    return (jax.nn.silu(g) * u) @ w_down


def _trunk(x, mem, mla_p, diff_p, xa_p, ffn_p):
    for i in range(DEPTH):
        j = i // N_MIXERS
        if i % N_MIXERS == 0:
            x = x + _mla(x, *[p[j] for p in mla_p])
        else:
            x = x + _diff_attn(x, i, *[p[j] for p in diff_p])
        x = x + _mem_xattn(x, mem, *[p[i] for p in xa_p])
        x = x + _conv_glu(x, *[p[i] for p in ffn_p])
    return x


def setup_inputs(seed: int = 0) -> dict:
    key = jax.random.key(seed)
    keys = iter(jax.random.split(key, 32))
    f32 = jnp.float32

    def w(shape, fan_in):
        return jax.random.normal(next(keys), shape, f32) * (fan_in ** -0.5)

    def g(shape):
        return 1.0 + 0.02 * jax.random.normal(next(keys), shape, f32)

    D = D_MODEL
    A, B = N_LAYERS_A, N_LAYERS_B
    return {
        'x_prompt': jax.random.normal(next(keys), (BATCH, SEQ, D), f32),
        'x_sample': jax.random.normal(next(keys), (DEC_BATCH, DEC_SEQ, D), f32),
        'mem_prompt': jax.random.normal(next(keys), (BATCH, N_MEM, D), f32),
        'mem_sample': jax.random.normal(next(keys), (DEC_BATCH, N_MEM, D), f32),
        'mla_norm': g((A, D)),
        'mla_w_down': w((A, D, MLA_Q_LORA + MLA_KV_LORA + MLA_ROPE), D),
        'mla_q_lat_norm': g((A, MLA_Q_LORA)),
        'mla_kv_lat_norm': g((A, MLA_KV_LORA)),
        'mla_w_uq': w((A, MLA_Q_LORA, MLA_HEADS * MLA_QK), MLA_Q_LORA),
        'mla_w_ukv': w((A, MLA_KV_LORA, MLA_HEADS * (MLA_NOPE + MLA_V)), MLA_KV_LORA),
        'mla_q_norm': g((A, MLA_QK)),
        'mla_k_norm': g((A, MLA_QK)),
        'mla_w_o': w((A, MLA_HEADS * MLA_V, D), MLA_HEADS * MLA_V),
        'diff_norm': g((B, D)),
        'diff_w_qkv': w((B, D, 3 * DIFF_HEADS * 2 * DIFF_HD), D),
        'diff_q_norm': g((B, 2, DIFF_HD)),
        'diff_k_norm': g((B, 2, DIFF_HD)),
        'diff_lambda': 0.1 * jax.random.normal(next(keys), (B, 4, DIFF_HD), f32),
        'diff_sub_norm': g((B, 2 * DIFF_HD)),
        'diff_w_o': w((B, DIFF_HEADS * 2 * DIFF_HD, D), DIFF_HEADS * 2 * DIFF_HD),
        'xa_norm': g((DEPTH, D)),
        'xa_mem_norm': g((DEPTH, D)),
        'xa_w_q': w((DEPTH, D, XA_HEADS * XA_HD), D),
        'xa_w_kv': w((DEPTH, D, 2 * XA_HEADS * XA_HD), D),
        'xa_q_norm': g((DEPTH, XA_HD)),
        'xa_k_norm': g((DEPTH, XA_HD)),
        'xa_w_o': w((DEPTH, XA_HEADS * XA_HD, D), XA_HEADS * XA_HD),
        'ffn_norm': g((DEPTH, D)),
        'ffn_w_gu': w((DEPTH, D, 2 * D_FF), D),
        'ffn_conv_w': w((DEPTH, CONV_W, D_FF), CONV_W),
        'ffn_conv_b': 0.02 * jax.random.normal(next(keys), (DEPTH, D_FF), f32),
        'ffn_w_down': w((DEPTH, D_FF, D), D_FF),
    }


def reference(x_prompt, x_sample, mem_prompt, mem_sample,
              mla_norm, mla_w_down, mla_q_lat_norm, mla_kv_lat_norm, mla_w_uq, mla_w_ukv,
              mla_q_norm, mla_k_norm, mla_w_o,
              diff_norm, diff_w_qkv, diff_q_norm, diff_k_norm, diff_lambda, diff_sub_norm, diff_w_o,
              xa_norm, xa_mem_norm, xa_w_q, xa_w_kv, xa_q_norm, xa_k_norm, xa_w_o,
              ffn_norm, ffn_w_gu, ffn_conv_w, ffn_conv_b, ffn_w_down):
    mla_p = (mla_norm, mla_w_down, mla_q_lat_norm, mla_kv_lat_norm, mla_w_uq, mla_w_ukv,
             mla_q_norm, mla_k_norm, mla_w_o)
    diff_p = (diff_norm, diff_w_qkv, diff_q_norm, diff_k_norm, diff_lambda, diff_sub_norm, diff_w_o)
    xa_p = (xa_norm, xa_mem_norm, xa_w_q, xa_w_kv, xa_q_norm, xa_k_norm, xa_w_o)
    ffn_p = (ffn_norm, ffn_w_gu, ffn_conv_w, ffn_conv_b, ffn_w_down)
    y_prompt = _trunk(x_prompt, mem_prompt, mla_p, diff_p, xa_p, ffn_p)
    y_sample = _trunk(x_sample, mem_sample, mla_p, diff_p, xa_p, ffn_p)
    return (y_prompt, y_sample)
```

```cpp
#include <hip/hip_runtime.h>
#include <hip/hip_cooperative_groups.h>
#include <cstdio>
#include <cstdint>
namespace cg = cooperative_groups;

#ifndef REP_GU
#define REP_GU 1
#endif
#ifndef REP_MLA
#define REP_MLA 1
#endif
#ifndef REP_DIFF
#define REP_DIFF 1
#endif
#ifndef REP_XA
#define REP_XA 1
#endif
#ifndef MULTI_LAUNCH
#define MULTI_LAUNCH 0
#endif

typedef unsigned short bf16_t;
typedef short bf16x8 __attribute__((ext_vector_type(8)));
typedef float f32x16 __attribute__((ext_vector_type(16)));
typedef float f32x4 __attribute__((ext_vector_type(4)));
typedef unsigned u32x4 __attribute__((ext_vector_type(4)));
typedef unsigned u32x2 __attribute__((ext_vector_type(2)));
typedef __bf16 bf2_t __attribute__((ext_vector_type(2)));
#define DI __device__ __forceinline__
#define MFMA(a, b, c) __builtin_amdgcn_mfma_f32_32x32x16_bf16((a), (b), (c), 0, 0, 0)

constexpr int TP = 65536, TS = 32768, T = 98304, NMEMT = 6144;
constexpr int HALF_T = 49152;
constexpr float EPS = 1e-6f;
constexpr float LOG2E = 1.4426950408889634f;
constexpr int NTHR = 512, NW = 8;
constexpr int LDS_MAIN = 147456;
constexpr int LDS_BYTES = LDS_MAIN + 16;
constexpr int NPHASE = 39;

constexpr size_t OFF_W_MLA_DOWN = 0;
constexpr size_t OFF_W_MLA_UQ   = OFF_W_MLA_DOWN + 2ull * 768 * 1024 * 2;
constexpr size_t OFF_W_MLA_UKV  = OFF_W_MLA_UQ + 2ull * 768 * 384 * 2;
constexpr size_t OFF_W_MLA_WO   = OFF_W_MLA_UKV + 2ull * 1024 * 256 * 2;
constexpr size_t OFF_W_DIFF_QKV = OFF_W_MLA_WO + 2ull * 1024 * 512 * 2;
constexpr size_t OFF_W_DIFF_WO  = OFF_W_DIFF_QKV + 2ull * 3072 * 1024 * 2;
constexpr size_t OFF_W_XA_Q     = OFF_W_DIFF_WO + 2ull * 1024 * 1024 * 2;
constexpr size_t OFF_W_XA_KV    = OFF_W_XA_Q + 4ull * 1024 * 1024 * 2;
constexpr size_t OFF_W_XA_O     = OFF_W_XA_KV + 4ull * 2048 * 1024 * 2;
constexpr size_t OFF_W_FFN_GU   = OFF_W_XA_O + 4ull * 1024 * 1024 * 2;
constexpr size_t OFF_W_FFN_DOWN = OFF_W_FFN_GU + 4ull * 5632 * 1024 * 2;
constexpr size_t OFF_CONSTS     = OFF_W_FFN_DOWN + 4ull * 1024 * 2816 * 2;
constexpr size_t OFF_BAR        = OFF_CONSTS + 2048;
constexpr size_t OFF_ROPE       = OFF_CONSTS + 4096;
constexpr size_t OFF_XB         = OFF_ROPE + 8192ull * 32 * 4;
constexpr size_t OFF_MEMB       = OFF_XB + (size_t)T * 1024 * 2;
constexpr size_t OFF_MEMK       = OFF_MEMB + (size_t)NMEMT * 1024 * 2;
constexpr size_t OFF_MEMVT      = OFF_MEMK + 4ull * NMEMT * 1024 * 2;
constexpr size_t OFF_R          = OFF_MEMVT + 4ull * NMEMT * 1024 * 2;
constexpr size_t WS_END         = OFF_R + (size_t)T * 3072 * 2;
constexpr size_t OFF_XBAR       = WS_END;
constexpr size_t WS_NEED        = WS_END + 16384;
constexpr size_t OFF_ACT = OFF_R, OFF_GEDGE = OFF_ACT + (size_t)T * 2816 * 2, OFF_UEDGE = OFF_GEDGE + 384ull * 4 * 2816 * 2;
static_assert(OFF_UEDGE + 384ull * 2 * 2816 * 4 <= WS_END, "FFN overlay");

struct P { const float* in[32]; float* out; unsigned char* ws; };
typedef const P __attribute__((address_space(4)))* KargP;
__device__ __forceinline__ KargP get_kargs() {
#if defined(__HIP_DEVICE_COMPILE__)
  KargP pp = (KargP)__builtin_amdgcn_kernarg_segment_ptr();
  asm volatile("" : "+s"(pp));
  return pp;
#else
  return nullptr;
#endif
}

struct PrepJob { int src, L, K, N, Npad, gsrc; unsigned long long dst; };
__constant__ PrepJob JOBS[11] = {
  {5, 2, 1024, 672, 768, 4, OFF_W_MLA_DOWN},
  {8, 2, 384, 768, 768, 6, OFF_W_MLA_UQ},
  {9, 2, 256, 1024, 1024, 7, OFF_W_MLA_UKV},
  {12, 2, 512, 1024, 1024, -1, OFF_W_MLA_WO},
  {14, 2, 1024, 3072, 3072, 13, OFF_W_DIFF_QKV},
  {19, 2, 1024, 1024, 1024, -1, OFF_W_DIFF_WO},
  {22, 4, 1024, 1024, 1024, 20, OFF_W_XA_Q},
  {23, 4, 1024, 2048, 2048, 21, OFF_W_XA_KV},
  {26, 4, 1024, 1024, 1024, -1, OFF_W_XA_O},
  {28, 4, 1024, 5632, 5632, 27, OFF_W_FFN_GU},
  {31, 4, 2816, 1024, 1024, -1, OFF_W_FFN_DOWN},
};

DI int my_tid() { int t = threadIdx.x; asm volatile("" : "+v"(t)); return t; }
DI unsigned pk2(float a, float b) { bf2_t v; v[0] = (__bf16)a; v[1] = (__bf16)b; return __builtin_bit_cast(unsigned, v); }
DI float bflo(unsigned u) { return __uint_as_float(u << 16); }
DI float bfhi(unsigned u) { return __uint_as_float(u & 0xffff0000u); }
DI float dot2s(unsigned u, float c) { bf2_t v = __builtin_bit_cast(bf2_t, u); return __builtin_amdgcn_fdot2_f32_bf16(v, v, c, false); }
DI float ssq8(bf16x8 x, float c) { u32x4 u = __builtin_bit_cast(u32x4, x); c = dot2s(u[0], c); c = dot2s(u[1], c); c = dot2s(u[2], c); c = dot2s(u[3], c); return c; }
DI void tok_info(int t, int& seq_start, int& S) { if (t < TP) { seq_start = t & ~8191; S = 8192; } else { seq_start = TP + ((t - TP) & ~2047); S = 2048; } }
DI void st_bf16(bf16_t* p, float v) { *p = (bf16_t)(pk2(v, 0.f) & 0xffffu); }

DI void phase_prep(KargP p, unsigned char* smem) {
  const int tid = my_tid();
  {
    float* tile = (float*)smem;
    int total = 0;
    for (int j = 0; j < 11; ++j) total += JOBS[j].L * (JOBS[j].K / 64) * (JOBS[j].Npad / 64);
    const int tx4 = tid & 15, ty4 = tid >> 4;
    float v[8], vn[8];
    bf16_t* dst = nullptr; int dK = 0; bf16_t* dstn = nullptr; int dKn = 0;
#define PREP_LOAD(TIX, V, DST, DK) do { int j = 0, rem = (TIX); \
      for (;;) { const int n_ = JOBS[j].L * (JOBS[j].K / 64) * (JOBS[j].Npad / 64); if (rem < n_) break; rem -= n_; ++j; } \
      const int K = JOBS[j].K, N = JOBS[j].N, Npad = JOBS[j].Npad, nkt = K / 64, nnt = Npad / 64; \
      const int l = rem / (nkt * nnt); rem -= l * nkt * nnt; \
      const int kt = rem / nnt, nt = rem % nnt, k0 = kt * 64, n0 = nt * 64; \
      const float* W = p->in[JOBS[j].src] + (size_t)l * K * N; \
      const float* g = JOBS[j].gsrc >= 0 ? p->in[JOBS[j].gsrc] + (size_t)l * K : nullptr; \
      int n = n0 + 4 * tx4; \
      if (j == 9) { const int jb = n0 >> 8, w = n0 & 255; n = (w < 128 ? jb * 128 + w : 2816 + jb * 128 + (w - 128)) + 4 * tx4; }     \
      _Pragma("unroll") for (int q = 0; q < 2; ++q) { const int kk = ty4 + 32 * q; f32x4 x = {0.f, 0.f, 0.f, 0.f}; if (n < N) x = __builtin_nontemporal_load((const f32x4*)(W + (size_t)(k0 + kk) * N + n));     \
        const float gk = g ? g[k0 + kk] : 1.f; V[4 * q] = x[0] * gk; V[4 * q + 1] = x[1] * gk; V[4 * q + 2] = x[2] * gk; V[4 * q + 3] = x[3] * gk; } \
      DST = (bf16_t*)(p->ws + JOBS[j].dst) + (size_t)l * Npad * K + (size_t)n0 * K + k0; DK = K; } while (0)
    int tix = blockIdx.x;
    if (tix < total) PREP_LOAD(tix, v, dst, dK);
    for (; tix < total; tix += gridDim.x) {
      const int nx = tix + gridDim.x;
      if (nx < total) PREP_LOAD(nx, vn, dstn, dKn);
      __syncthreads();
#pragma unroll
      for (int q = 0; q < 2; ++q)
#pragma unroll
        for (int jj = 0; jj < 4; ++jj) tile[(ty4 + 32 * q) * 65 + 4 * tx4 + jj] = v[4 * q + jj];
      __syncthreads();
      const int kp = (tid & 15) * 4, nb = tid >> 4;
#pragma unroll
      for (int jn = 0; jn < 2; ++jn) {
        const int nn = nb + 32 * jn;
        u32x2 w; w[0] = pk2(tile[kp * 65 + nn], tile[(kp + 1) * 65 + nn]); w[1] = pk2(tile[(kp + 2) * 65 + nn], tile[(kp + 3) * 65 + nn]);
        *(u32x2*)(dst + (size_t)nn * dK + kp) = w;
      }
#pragma unroll
      for (int q = 0; q < 8; ++q) v[q] = vn[q];
      dst = dstn; dK = dKn;
    }
#undef PREP_LOAD
  }
  const int lane = tid & 63, gw = blockIdx.x * NW + (tid >> 6), nw = gridDim.x * NW;
  {
    bf16_t* xb = (bf16_t*)(p->ws + OFF_XB);
    for (int row = gw; row < T; row += 2 * nw) {
      const int row2 = row + nw < T ? row + nw : row;
      const float* src = row < TP ? p->in[0] + (size_t)row * 1024 : p->in[1] + (size_t)(row - TP) * 1024;
      const float* src2 = row2 < TP ? p->in[0] + (size_t)row2 * 1024 : p->in[1] + (size_t)(row2 - TP) * 1024;
      f32x4 va[4], vb[4];
#pragma unroll
      for (int i = 0; i < 4; ++i) { va[i] = __builtin_nontemporal_load((const f32x4*)(src + lane * 4 + 256 * i)); vb[i] = __builtin_nontemporal_load((const f32x4*)(src2 + lane * 4 + 256 * i)); }
#pragma unroll
      for (int i = 0; i < 4; ++i) {
        const int c = lane * 4 + 256 * i;
        u32x2 w; w[0] = pk2(va[i][0], va[i][1]); w[1] = pk2(va[i][2], va[i][3]);
        *(u32x2*)(xb + (size_t)row * 1024 + c) = w;
        u32x2 w2; w2[0] = pk2(vb[i][0], vb[i][1]); w2[1] = pk2(vb[i][2], vb[i][3]);
        *(u32x2*)(xb + (size_t)row2 * 1024 + c) = w2;
      }
    }
  }
  {
    bf16_t* mb = (bf16_t*)(p->ws + OFF_MEMB);
    for (int row = gw; row < NMEMT; row += nw) {
      const float* src = row < 2048 ? p->in[2] + (size_t)row * 1024 : p->in[3] + (size_t)(row - 2048) * 1024;
      f32x4 v[4]; float ss = 0.f;
#pragma unroll
      for (int i = 0; i < 4; ++i) { v[i] = *(const f32x4*)(src + lane * 4 + 256 * i); ss += v[i][0] * v[i][0] + v[i][1] * v[i][1] + v[i][2] * v[i][2] + v[i][3] * v[i][3]; }
#pragma unroll
      for (int m = 1; m < 64; m <<= 1) ss += __shfl_xor(ss, m);
      const float rs = rsqrtf(ss * (1.0f / 1024.0f) + EPS);
#pragma unroll
      for (int i = 0; i < 4; ++i) { u32x2 w; w[0] = pk2(v[i][0] * rs, v[i][1] * rs); w[1] = pk2(v[i][2] * rs, v[i][3] * rs); *(u32x2*)(mb + (size_t)row * 1024 + lane * 4 + 256 * i) = w; }
    }
  }
  {
    float* rt = (float*)(p->ws + OFF_ROPE);
    for (int idx = blockIdx.x * NTHR + tid; idx < 8192 * 16; idx += gridDim.x * NTHR) {
      const int pos = idx >> 4, i = idx & 15;
      const float inv = powf(10000.0f, -(float)i / 16.0f);
      const float ang = (float)pos * inv;
      float s, c; sincosf(ang, &s, &c);
      rt[pos * 32 + i] = c; rt[pos * 32 + 16 + i] = s;
    }
  }
  if (blockIdx.x == 0) {
    float* cf = (float*)(p->ws + OFF_CONSTS);
    int* ctr = (int*)(p->ws + OFF_CONSTS + 256);
    if (tid < 64) ctr[tid] = 0;
    const int wid = tid >> 6;
    auto absmax = [&](const float* g, int n) { float m = 0.f; for (int i = lane; i < n; i += 64) m = fmaxf(m, fabsf(g[i])); for (int s = 1; s < 64; s <<= 1) m = fmaxf(m, __shfl_xor(m, s)); return m; };
    if (wid == 0) {
      for (int j = 0; j < 2; ++j) {
        const float mq = absmax(p->in[10] + j * 96, 96), mk = absmax(p->in[11] + j * 96, 96);
        const float M = 96.f * mq * mk * 0.10206207261596577f * LOG2E * 1.03f + 0.25f;
        if (lane == 0) cf[j] = M;
      }
    } else if (wid == 1) {
      for (int j = 0; j < 2; ++j) {
        const float mq = absmax(p->in[15] + j * 128, 128), mk = absmax(p->in[16] + j * 128, 128);
        const float M = 64.f * mq * mk * 0.125f * LOG2E * 1.03f + 0.25f;
        if (lane == 0) cf[2 + j] = M;
      }
    } else if (wid == 2) {
      for (int j = 0; j < 2; ++j) {
        const float* lp = p->in[17] + j * 256;
        float a = lp[lane] * lp[64 + lane], b = lp[128 + lane] * lp[192 + lane];
        for (int s = 1; s < 64; s <<= 1) { a += __shfl_xor(a, s); b += __shfl_xor(b, s); }
        const float linit = 0.8f - 0.6f * expf(-0.3f * (float)(2 * j + 1));
        if (lane == 0) cf[4 + j] = expf(a) - expf(b) + linit;
      }
    } else if (wid == 3) {
      for (int i = 0; i < 4; ++i) {
        const float mq = absmax(p->in[24] + i * 256, 256), mk = absmax(p->in[25] + i * 256, 256);
        const float M = 256.f * mq * mk * 0.0625f * LOG2E * 1.03f + 0.25f;
        if (lane == 0) cf[6 + i] = M;
      }
    }
  }
}

DI void memk_norm(KargP p) {
  const int tid = my_tid(), lane = tid & 63, gw = blockIdx.x * NW + (tid >> 6), nw = gridDim.x * NW;
  bf16_t* mk = (bf16_t*)(p->ws + OFF_MEMK);
  for (int row = gw; row < 4 * NMEMT * 4; row += nw) {
    const int l = row / (NMEMT * 4);
    bf16_t* ptr = mk + (size_t)row * 256 + lane * 4;
    const u32x2 u = *(const u32x2*)ptr;
    float x0 = bflo(u[0]), x1 = bfhi(u[0]), x2 = bflo(u[1]), x3 = bfhi(u[1]);
    float ss = x0 * x0 + x1 * x1 + x2 * x2 + x3 * x3;
#pragma unroll
    for (int m = 1; m < 64; m <<= 1) ss += __shfl_xor(ss, m);
    const float rs = rsqrtf(ss * (1.0f / 256.0f) + EPS);
    const f32x4 g = *(const f32x4*)(p->in[25] + l * 256 + lane * 4);
    u32x2 w; w[0] = pk2(x0 * rs * g[0], x1 * rs * g[1]); w[1] = pk2(x2 * rs * g[2], x3 * rs * g[3]);
    *(u32x2*)ptr = w;
  }
}

enum { EPI_PLAIN = 0, EPI_RES = 1, EPI_MLAKV = 2, EPI_DIFFQKV = 3, EPI_MEMKV = 4, EPI_GUCONV = 5 };
struct EpiArgs {
  bf16_t* o0; bf16_t* o1; bf16_t* o2; int ldc; int nvalid;
  float* X; bf16_t* XB;
  const float* g0; const float* g1; const bf16_t* aux; const float* rope; int nostore;
  const float* cw; const float* cb; bf16_t* gedge; bf16_t* uedge;
};

template <int EPI, bool RS>
DI void gemm_epilogue(unsigned char* smem, f32x16 (&acc)[2][4], const float (&ssq)[4], int K, int m0, int nt256, const EpiArgs& ea, int wt, int wf, int r, int h) {
  asm volatile("" : "+v"(r), "+v"(h));
  const int nt = nt256 * 2 + (wf >> 1), wc = wf & 1;
  const int n0 = nt * 128;
  float rstd[4] = {1.f, 1.f, 1.f, 1.f};
  if (RS) {
#pragma unroll
    for (int tb = 0; tb < 4; ++tb) { float s = ssq[tb]; s += __shfl_xor(s, 32); rstd[tb] = rsqrtf(s / (float)K + EPS); }
  }
  if (EPI == EPI_PLAIN) {
#pragma unroll
    for (int tb = 0; tb < 4; ++tb) {
      const int tok = m0 + wt * 128 + tb * 32 + r; const float rs = rstd[tb];
      bf16_t* rowp = ea.o0 + (size_t)tok * ea.ldc;
#pragma unroll
      for (int fb = 0; fb < 2; ++fb)
#pragma unroll
        for (int g4 = 0; g4 < 4; ++g4) {
          const int col = n0 + wc * 64 + fb * 32 + g4 * 8 + 4 * h;
          if (col < ea.nvalid && !ea.nostore) { u32x2 w; w[0] = pk2(acc[fb][tb][4 * g4] * rs, acc[fb][tb][4 * g4 + 1] * rs); w[1] = pk2(acc[fb][tb][4 * g4 + 2] * rs, acc[fb][tb][4 * g4 + 3] * rs); *(u32x2*)(rowp + col) = w; }
        }
    }
  } else if (EPI == EPI_RES) {
    unsigned char* es = smem + 73728;
    constexpr int EP = 528;
    const int tid = ((wt * 4 + wf) * 2 + h) * 32 + r;
#pragma unroll
    for (int hf = 0; hf < 2; ++hf) {
      if (wt == hf) {
#pragma unroll
        for (int tb = 0; tb < 4; ++tb)
#pragma unroll
          for (int fb = 0; fb < 2; ++fb)
#pragma unroll
            for (int g4 = 0; g4 < 4; ++g4) {
              u32x2 w; w[0] = pk2(acc[fb][tb][4 * g4], acc[fb][tb][4 * g4 + 1]); w[1] = pk2(acc[fb][tb][4 * g4 + 2], acc[fb][tb][4 * g4 + 3]);
              *(u32x2*)(es + (tb * 32 + r) * EP + (wf * 64 + fb * 32 + g4 * 8 + 4 * h) * 2) = w;
            }
      }
      __syncthreads();
#pragma unroll
      for (int i = 0; i < 8; ++i) {
        const int c = tid + NTHR * i, row = c >> 5, kc = c & 31;
        const u32x4 d = *(const u32x4*)(es + row * EP + kc * 16);
        const size_t off = (size_t)(m0 + hf * 128 + row) * 1024 + nt256 * 256 + kc * 8;
        const u32x4 xo = *(const u32x4*)(ea.XB + off);
        float xn[8];
#pragma unroll
        for (int j = 0; j < 4; ++j) { xn[2 * j] = bflo(xo[j]) + bflo(d[j]); xn[2 * j + 1] = bfhi(xo[j]) + bfhi(d[j]); }
        if (ea.X) {
          f32x4 o0 = {xn[0], xn[1], xn[2], xn[3]}, o1 = {xn[4], xn[5], xn[6], xn[7]};
          __builtin_nontemporal_store(o0, (f32x4*)(ea.X + off)); __builtin_nontemporal_store(o1, (f32x4*)(ea.X + off + 4));
        } else {
          u32x4 w;
#pragma unroll
          for (int j = 0; j < 4; ++j) w[j] = pk2(xn[2 * j], xn[2 * j + 1]);
          *(u32x4*)(ea.XB + off) = w;
        }
      }
      __syncthreads();
    }
  } else if (EPI == EPI_MLAKV) {
    const int head = nt;
    if (wc == 0) {
#pragma unroll
      for (int tb = 0; tb < 4; ++tb) {
        const int tok = m0 + wt * 128 + tb * 32 + r; int ss0, S; tok_info(tok, ss0, S); const int pos = tok - ss0;
        const float a = rstd[tb]; float ss = 0.f;
#pragma unroll
        for (int fb = 0; fb < 2; ++fb)
#pragma unroll
          for (int i = 0; i < 16; ++i) { const float v = acc[fb][tb][i] * a; acc[fb][tb][i] = v; ss += v * v; }
        const bf16_t* cr = ea.aux + (size_t)tok * 672 + 640;
        {
          const u32x4 r0 = *(const u32x4*)(cr + 8 * h), r1 = *(const u32x4*)(cr + 16 + 8 * h);
#pragma unroll
          for (int j = 0; j < 4; ++j) { ss = dot2s(r0[j], ss); ss = dot2s(r1[j], ss); }
        }
        ss += __shfl_xor(ss, 32);
        const float rr = rsqrtf(ss * (1.0f / 96.0f) + EPS);
        bf16_t* ko = ea.o0 + (size_t)tok * 768 + head * 96;
#pragma unroll
        for (int fb = 0; fb < 2; ++fb)
#pragma unroll
          for (int g4 = 0; g4 < 4; ++g4) {
            const int d = fb * 32 + g4 * 8 + 4 * h;
            const f32x4 g = *(const f32x4*)(ea.g0 + d);
            u32x2 w; w[0] = pk2(acc[fb][tb][4 * g4] * rr * g[0], acc[fb][tb][4 * g4 + 1] * rr * g[1]); w[1] = pk2(acc[fb][tb][4 * g4 + 2] * rr * g[2], acc[fb][tb][4 * g4 + 3] * rr * g[3]);
            *(u32x2*)(ko + d) = w;
          }
        __builtin_amdgcn_sched_barrier(0);
        asm volatile("" : "+v"(cr));
        const u32x4 r0 = *(const u32x4*)(cr + 8 * h), r1 = *(const u32x4*)(cr + 16 + 8 * h);
        float x0[8], x1[8];
#pragma unroll
        for (int j = 0; j < 4; ++j) { x0[2 * j] = bflo(r0[j]); x0[2 * j + 1] = bfhi(r0[j]); x1[2 * j] = bflo(r1[j]); x1[2 * j + 1] = bfhi(r1[j]); }
        const float* rt = ea.rope + (size_t)pos * 32;
        float y0[8], y1[8];
#pragma unroll
        for (int j = 0; j < 8; ++j) {
          const int i = 8 * h + j; const float c = rt[i], s = rt[16 + i];
          const float a0 = x0[j] * rr * ea.g0[64 + i], a1 = x1[j] * rr * ea.g0[80 + i];
          y0[j] = a0 * c - a1 * s; y1[j] = a1 * c + a0 * s;
        }
        u32x4 w0, w1;
#pragma unroll
        for (int j = 0; j < 4; ++j) { w0[j] = pk2(y0[2 * j], y0[2 * j + 1]); w1[j] = pk2(y1[2 * j], y1[2 * j + 1]); }
        *(u32x4*)(ko + 64 + 8 * h) = w0; *(u32x4*)(ko + 80 + 8 * h) = w1;
        __builtin_amdgcn_sched_barrier(0);
      }
    } else {
#pragma unroll
      for (int tb = 0; tb < 4; ++tb) {
        const int tok = m0 + wt * 128 + tb * 32 + r; int ss0, S; tok_info(tok, ss0, S); const int pos = tok - ss0;
        const float a = rstd[tb];
        const unsigned vb = ((unsigned)ss0 * 512u + (unsigned)(head * 64 + 4 * h) * (unsigned)S + (unsigned)pos) * 2u, eS = (unsigned)S * 2u;
#pragma unroll
        for (int fb = 0; fb < 2; ++fb)
#pragma unroll
          for (int i = 0; i < 16; ++i) { const unsigned e = fb * 32 + 8 * (i >> 2) + (i & 3); st_bf16((bf16_t*)((char*)ea.o1 + (vb + e * eS)), acc[fb][tb][i] * a); }
      }
    }
  } else if (EPI == EPI_DIFFQKV) {
    const int sec = nt >> 3, head = nt & 7;
    if (sec < 2) {
      const float* g = (sec == 0 ? ea.g0 : ea.g1) + wc * 64; const float sc = sec == 0 ? 0.125f * LOG2E : 1.f; bf16_t* ob = sec == 0 ? ea.o0 : ea.o1;
#pragma unroll
      for (int tb = 0; tb < 4; ++tb) {
        const int tok = m0 + wt * 128 + tb * 32 + r; const float a = rstd[tb]; float ss = 0.f;
#pragma unroll
        for (int fb = 0; fb < 2; ++fb)
#pragma unroll
          for (int i = 0; i < 16; ++i) { const float v = acc[fb][tb][i] * a; acc[fb][tb][i] = v; ss += v * v; }
        ss += __shfl_xor(ss, 32);
        const float rr = rsqrtf(ss * (1.0f / 64.0f) + EPS) * sc;
        bf16_t* op = ob + (size_t)tok * 1024 + head * 128 + wc * 64;
#pragma unroll
        for (int fb = 0; fb < 2; ++fb)
#pragma unroll
          for (int g4 = 0; g4 < 4; ++g4) {
            const int d = fb * 32 + g4 * 8 + 4 * h;
            const f32x4 gg = *(const f32x4*)(g + d);
            u32x2 w; w[0] = pk2(acc[fb][tb][4 * g4] * rr * gg[0], acc[fb][tb][4 * g4 + 1] * rr * gg[1]); w[1] = pk2(acc[fb][tb][4 * g4 + 2] * rr * gg[2], acc[fb][tb][4 * g4 + 3] * rr * gg[3]);
            *(u32x2*)(op + d) = w;
          }
      }
    } else {
#pragma unroll
      for (int tb = 0; tb < 4; ++tb) {
        const int tok = m0 + wt * 128 + tb * 32 + r; int ss0, S; tok_info(tok, ss0, S); const int pos = tok - ss0;
        const float a = rstd[tb];
        const unsigned vb = ((unsigned)ss0 * 1024u + (unsigned)(head * 128) * (unsigned)S + (unsigned)(pos >> 5) * 4096u + (unsigned)(wc * 64 + 4 * h) * 32u + (unsigned)(pos & 31)) * 2u, eS = 64u;
#pragma unroll
        for (int fb = 0; fb < 2; ++fb)
#pragma unroll
          for (int i = 0; i < 16; ++i) { const unsigned e = fb * 32 + 8 * (i >> 2) + (i & 3); st_bf16((bf16_t*)((char*)ea.o2 + (vb + e * eS)), acc[fb][tb][i] * a); }
      }
    }
  } else if (EPI == EPI_MEMKV) {
    if (nt < 8) {
#pragma unroll
      for (int tb = 0; tb < 4; ++tb) {
        const int tok = m0 + wt * 128 + tb * 32 + r;
        bf16_t* rowp = ea.o0 + (size_t)tok * 1024 + n0 + wc * 64;
#pragma unroll
        for (int fb = 0; fb < 2; ++fb)
#pragma unroll
          for (int g4 = 0; g4 < 4; ++g4) {
            u32x2 w; w[0] = pk2(acc[fb][tb][4 * g4], acc[fb][tb][4 * g4 + 1]); w[1] = pk2(acc[fb][tb][4 * g4 + 2], acc[fb][tb][4 * g4 + 3]);
            *(u32x2*)(rowp + fb * 32 + g4 * 8 + 4 * h) = w;
          }
      }
    } else {
      const int cbase = (nt - 8) * 128 + wc * 64, head = cbase >> 8, e0 = cbase & 255;
#pragma unroll
      for (int tb = 0; tb < 4; ++tb) {
        const int tok = m0 + wt * 128 + tb * 32 + r, seq = tok >> 8, key = tok & 255;
        const unsigned vb = ((((unsigned)(seq * 4 + head) * 8u + (unsigned)(key >> 5)) * 256u + (unsigned)(e0 + 4 * h)) * 32u + (unsigned)(key & 31)) * 2u;
#pragma unroll
        for (int fb = 0; fb < 2; ++fb)
#pragma unroll
          for (int i = 0; i < 16; ++i) { const unsigned e = fb * 32 + 8 * (i >> 2) + (i & 3); st_bf16((bf16_t*)((char*)ea.o1 + (vb + e * 64u)), acc[fb][tb][i]); }
      }
    }
  }
  if (EPI == EPI_GUCONV) {
    constexpr int GP = 272;
    const int fw = (wf & 1) * 64, jb = nt256, mt = m0 >> 8;
    {
      unsigned char* dst = smem + (wf < 2 ? 0 : 73728);
#pragma unroll
      for (int tb = 0; tb < 4; ++tb) {
        const int rr = wt * 128 + tb * 32 + r; const float rs = rstd[tb];
#pragma unroll
        for (int fb = 0; fb < 2; ++fb)
#pragma unroll
          for (int g4 = 0; g4 < 4; ++g4) {
            const int f = fw + fb * 32 + g4 * 8 + 4 * h;
            u32x2 w; w[0] = pk2(acc[fb][tb][4 * g4] * rs, acc[fb][tb][4 * g4 + 1] * rs); w[1] = pk2(acc[fb][tb][4 * g4 + 2] * rs, acc[fb][tb][4 * g4 + 3] * rs);
            *(u32x2*)(dst + rr * GP + f * 2) = w;
          }
      }
    }
    __syncthreads();
    {
      const unsigned char* gs_ = smem; const unsigned char* us_ = smem + 73728;
      const int tid = ((wt * 4 + wf) * 2 + h) * 32 + r, kc = tid & 15, r0 = tid >> 4, fg = jb * 128 + kc * 8;
      float w0[8], w1[8], w2[8], bb[8];
#pragma unroll
      for (int q4 = 0; q4 < 2; ++q4) {
        const f32x4 a0 = *(const f32x4*)(ea.cw + fg + 4 * q4), a1 = *(const f32x4*)(ea.cw + 2816 + fg + 4 * q4), a2 = *(const f32x4*)(ea.cw + 5632 + fg + 4 * q4), a3 = *(const f32x4*)(ea.cb + fg + 4 * q4);
#pragma unroll
        for (int j = 0; j < 4; ++j) { w0[4 * q4 + j] = a0[j]; w1[4 * q4 + j] = a1[j]; w2[4 * q4 + j] = a2[j]; bb[4 * q4 + j] = a3[j]; }
      }
#pragma unroll
      for (int i = 0; i < 8; ++i) {
        const int row = r0 + 32 * i;
        const int rm = (i == 0 && row == 0) ? 0 : row - 1, rp = (i == 7 && row == 255) ? 255 : row + 1;
        u32x4 gm = *(const u32x4*)(gs_ + rm * GP + kc * 16);
        const u32x4 gc = *(const u32x4*)(gs_ + row * GP + kc * 16);
        u32x4 gp = *(const u32x4*)(gs_ + rp * GP + kc * 16);
        const u32x4 uu = *(const u32x4*)(us_ + row * GP + kc * 16);
        if (i == 0) { const bool z = row == 0;
#pragma unroll
          for (int j = 0; j < 4; ++j) gm[j] = z ? 0u : gm[j]; }
        if (i == 7) { const bool z = row == 255;
#pragma unroll
          for (int j = 0; j < 4; ++j) gp[j] = z ? 0u : gp[j]; }
        u32x4 o;
#pragma unroll
        for (int j = 0; j < 4; ++j) {
          const float a0 = w0[2 * j] * bflo(gm[j]) + w1[2 * j] * bflo(gc[j]) + w2[2 * j] * bflo(gp[j]) + bb[2 * j];
          const float a1 = w0[2 * j + 1] * bfhi(gm[j]) + w1[2 * j + 1] * bfhi(gc[j]) + w2[2 * j + 1] * bfhi(gp[j]) + bb[2 * j + 1];
          const float s0 = a0 * __builtin_amdgcn_rcpf(1.f + __builtin_amdgcn_exp2f(-LOG2E * a0)), s1 = a1 * __builtin_amdgcn_rcpf(1.f + __builtin_amdgcn_exp2f(-LOG2E * a1));
          o[j] = pk2(s0 * bflo(uu[j]), s1 * bfhi(uu[j]));
        }
        *(u32x4*)(ea.o0 + (size_t)(m0 + row) * 2816 + fg) = o;
        if (i == 0 && row < 2) { *(u32x4*)(ea.gedge + (size_t)(mt * 4 + row) * 2816 + fg) = gc; if (row == 0) *(u32x4*)(ea.uedge + (size_t)(mt * 2) * 2816 + fg) = uu; }
        if (i == 7 && row >= 254) { *(u32x4*)(ea.gedge + (size_t)(mt * 4 + row - 252) * 2816 + fg) = gc; if (row == 255) *(u32x4*)(ea.uedge + (size_t)(mt * 2 + 1) * 2816 + fg) = uu; }
      }
    }
    __syncthreads();
  }
}

DI void map_tile(int L, int nMt, int nNt, int& pm, int& pn) {
  const int total = nMt * nNt, q = total >> 3, rr = total & 7, xcd = L & 7, off = L >> 3;
  const int wg = (xcd < rr ? xcd * (q + 1) : rr * (q + 1) + (xcd - rr) * q) + off;
  constexpr int WGM = 8;
  const int nig = WGM * nNt, gid = wg / nig, fm = gid * WGM, gsz = (nMt - fm) < WGM ? (nMt - fm) : WGM;
  pm = fm + (wg % nig) % gsz; pn = (wg % nig) / gsz;
}

template <int EPI, bool RS>
DI void gemm_phase(unsigned char* smem, const bf16_t* __restrict__ A, int lda, const bf16_t* __restrict__ Bt, int K, int mt0, int nMt, int nNt, const EpiArgs& ea) {
  const int total = nMt * nNt;
  int tile = blockIdx.x;
  if (tile >= total) return;
  const int tid = my_tid(), lane = tid & 63, wid = tid >> 6, wt = wid >> 2, wf = wid & 3, r = lane & 31, h = lane >> 5;
  const int srow = tid >> 3, skc = tid & 7;
  const size_t astep = (size_t)128 * lda, bstep = (size_t)128 * K;
  const unsigned voffA = (unsigned)(srow * lda + skc * 8) * 2u, voffB = (unsigned)(srow * K + skc * 8) * 2u;
  const unsigned swoff = srow * 144 + skc * 16;
  const unsigned aoff = (wt * 128 + r) * 144 + h * 16, boff = 36864 + (wf * 64 + r) * 144 + h * 16;
  const int nk = K >> 6;
  constexpr bool DEEP = (EPI == EPI_PLAIN || EPI == EPI_RES || EPI == EPI_MEMKV);
  u32x4 rg[8], rh[DEEP ? 8 : 1];
#define G_LD2R(R, i, PA, PB) do { R[i] = *(const u32x4*)((PA) + (i) * astep + voffA); R[4 + (i)] = *(const u32x4*)((PB) + (i) * bstep + voffB); } while (0)
#define G_LD2(i, PA, PB) G_LD2R(rg, i, PA, PB)
#define G_WR2R(R, i, st) do { unsigned char* sw_ = smem + (st) * 73728 + swoff + (i) * 9216; *(u32x4*)(sw_) = R[i]; *(u32x4*)(sw_ + 36864) = R[4 + (i)]; } while (0)
#define G_WR2(i, st) G_WR2R(rg, i, st)
#define G_FRAGS(F, sb, s) do { F[0] = *(const bf16x8*)((sb) + boff + (s) * 32); F[1] = *(const bf16x8*)((sb) + boff + 4608 + (s) * 32); \
    _Pragma("unroll") for (int t_ = 0; t_ < 4; ++t_) F[2 + t_] = *(const bf16x8*)((sb) + aoff + t_ * 4608 + (s) * 32); } while (0)
#define G_MMA(F) do { if (RS) { _Pragma("unroll") for (int t_ = 0; t_ < 4; ++t_) ssq[t_] = ssq8(F[2 + t_], ssq[t_]); } \
    _Pragma("unroll") for (int t_ = 0; t_ < 4; ++t_) { acc[0][t_] = MFMA(F[0], F[2 + t_], acc[0][t_]); acc[1][t_] = MFMA(F[1], F[2 + t_], acc[1][t_]); } } while (0)
#define SB() __builtin_amdgcn_sched_barrier(0)
  int nt, mtl; map_tile(tile, nMt, nNt, mtl, nt);
  int m0 = (mt0 + mtl) * 256;
  const char* ga = (const char*)(A + (size_t)m0 * lda);
  const char* gb = (const char*)(Bt + (size_t)(nt * 256) * K);
  constexpr bool XPF = (EPI != EPI_MLAKV && EPI != EPI_GUCONV);
  constexpr bool XPR = (EPI == EPI_GUCONV);
  bf16x8 fa[6];
  bool first = true;
  for (;;) {
    if (!XPF || first) {
      if (!XPR || first) {
#pragma unroll
        for (int i = 0; i < 4; ++i) G_LD2(i, ga, gb);
      }
#pragma unroll
      for (int i = 0; i < 4; ++i) G_WR2(i, 0);
#pragma unroll
      for (int i = 0; i < 4; ++i) G_LD2(i, ga + 128, gb + 128);
      if (DEEP) {
#pragma unroll
        for (int i = 0; i < 4; ++i) G_LD2R(rh, i, ga + 256, gb + 256);
      }
      __syncthreads();
      first = false;
      G_FRAGS(fa, smem, 0);
    }
    const int ntile = tile + gridDim.x;
    const bool has_next = ntile < total;
    int nt_n = nt, m0_n = m0;
    if (has_next) { int pm_, pn_; map_tile(ntile, nMt, nNt, pm_, pn_); nt_n = pn_; m0_n = (mt0 + pm_) * 256; }
    const char* ga_n = (const char*)(A + (size_t)m0_n * lda);
    const char* gb_n = (const char*)(Bt + (size_t)(nt_n * 256) * K);
    f32x16 acc[2][4];
#pragma unroll
    for (int a = 0; a < 2; ++a)
#pragma unroll
      for (int b = 0; b < 4; ++b)
#pragma unroll
        for (int i = 0; i < 16; ++i) acc[a][b][i] = 0.f;
    float ssq[4] = {0.f, 0.f, 0.f, 0.f};
#define G_BODY(R, kt_, PA, PB) do { const unsigned char* sb_ = smem + ((kt_) & 1) * 73728; const unsigned char* sn_ = smem + (((kt_) + 1) & 1) * 73728; const int wst = ((kt_) + 1) & 1; \
        G_MMA(fa); SB(); G_WR2R(R, 0, wst); G_LD2R(R, 0, PA, PB); G_WR2R(R, 1, wst); G_LD2R(R, 1, PA, PB); G_FRAGS(fa, sb_, 1); SB(); \
        G_MMA(fa); SB(); G_WR2R(R, 2, wst); G_LD2R(R, 2, PA, PB); G_WR2R(R, 3, wst); G_LD2R(R, 3, PA, PB); G_FRAGS(fa, sb_, 2); SB(); \
        G_MMA(fa); SB(); G_FRAGS(fa, sb_, 3); SB(); \
        __syncthreads(); \
        G_MMA(fa); SB(); G_FRAGS(fa, sn_, 0); SB(); } while (0)
    if (DEEP) {
#define G_ITER(R, kt_) do { const int k3 = (kt_) + 3; \
        const char* pa = k3 < nk ? ga + k3 * 128 : ga_n + (k3 - nk) * 128; const char* pb = k3 < nk ? gb + k3 * 128 : gb_n + (k3 - nk) * 128; \
        G_BODY(R, kt_, pa, pb); } while (0)
      for (int kt = 0; kt < nk; kt += 2) { G_ITER(rg, kt); G_ITER(rh, kt + 1); }
#undef G_ITER
    } else {
      for (int kt = 0; kt < (XPR ? nk - 1 : nk); ++kt) {
        const int k2 = kt + 2;
        const char* pa = k2 < nk ? ga + k2 * 128 : ((XPF || XPR) ? ga_n + (k2 - nk) * 128 : ga);
        const char* pb = k2 < nk ? gb + k2 * 128 : ((XPF || XPR) ? gb_n + (k2 - nk) * 128 : gb);
        G_BODY(rg, kt, pa, pb);
      }
      if (XPR) {
        const unsigned char* sb_ = smem + 73728;
        G_MMA(fa); SB(); G_FRAGS(fa, sb_, 1); SB();
        G_MMA(fa); SB(); G_FRAGS(fa, sb_, 2); SB();
        G_MMA(fa); SB(); G_FRAGS(fa, sb_, 3); SB();
        __syncthreads();
        G_MMA(fa); SB();
      }
    }
#undef G_BODY
    gemm_epilogue<EPI, RS>(smem, acc, ssq, K, m0, nt, ea, wt, wf, r, h);
    if (!has_next) break;
    tile = ntile; nt = nt_n; m0 = m0_n; ga = ga_n; gb = gb_n;
  }
#undef G_LD2
#undef G_WR2
#undef G_LD2R
#undef G_WR2R
#undef G_FRAGS
#undef G_MMA
#undef SB
}

enum { AT_MLA = 0, AT_DIFF = 1, AT_XA = 2 };
struct AttnArgs {
  const bf16_t* Q; const bf16_t* K; const bf16_t* VT; bf16_t* O;
  const float* g0; const float* g1; const float* rope;
  float M; float lam; float oscale; int nostore;
};

template <int KS, int NMAP, int EB, int NKB, int MODE>
DI void attn_unit(unsigned char* smem, const AttnArgs& a, int t0, int head, int ehalf) {
  constexpr int DK = KS * 16 * NMAP, KP = DK * 2 + 16, KT = 32 * NKB, VP = KT * 2 + 16;
  constexpr int CPR = DK / 8, NCK = KT * CPR, NK_PER = (NCK + NTHR - 1) / NTHR, VCPR = KT / 8, NCV = EB * 32 * VCPR, NV_PER = (NCV + NTHR - 1) / NTHR;
  const int tid = my_tid(), lane = tid & 63, wid = tid >> 6, r = lane & 31, h = lane >> 5;
  constexpr int TILEB = KT * KP + EB * 32 * VP;
  int seq_start, S; tok_info(t0, seq_start, S);
  const int pos0 = t0 - seq_start;
  const int tq = t0 + wid * 32 + r, posq = pos0 + wid * 32 + r;
  const bf16_t* kbase; const bf16_t* vbase; size_t vpitch; int kpitch, nkeys; const bf16_t* qrow; bf16_t* orow;
  if (MODE == AT_MLA) {
    kpitch = 768; kbase = a.K + (size_t)seq_start * 768 + head * 96; vpitch = S; vbase = a.VT + (size_t)seq_start * 512 + (size_t)(head * 64) * S; nkeys = S;
    qrow = a.Q + (size_t)tq * 768 + head * 96; orow = a.O + (size_t)tq * 512 + head * 64;
  } else if (MODE == AT_DIFF) {
    kpitch = 1024; kbase = a.K + (size_t)seq_start * 1024 + head * 128; vpitch = 4096; vbase = a.VT + (size_t)seq_start * 1024 + (size_t)(head * 128) * S; nkeys = S;
    qrow = a.Q + (size_t)tq * 1024 + head * 128; orow = a.O + (size_t)tq * 1024 + head * 128;
  } else {
    const int seq = t0 < TP ? (t0 >> 13) : 8 + ((t0 - TP) >> 11);
    kpitch = 1024; kbase = a.K + (size_t)(seq * 256) * 1024 + head * 256; vpitch = 8192; vbase = a.VT + (size_t)(seq * 4 + head) * 65536 + ehalf * 4096; nkeys = 256;
    qrow = a.Q + (size_t)tq * 1024 + head * 256; orow = a.O + (size_t)tq * 1024 + head * 256 + ehalf * 128;
  }
  constexpr bool QLDS = (MODE == AT_DIFF);
  unsigned char* qs = smem + 2 * TILEB;
  const unsigned qoff = (wid * 32 + r) * KP + 16 * h;
  bf16x8 qf[QLDS ? 1 : NMAP * KS];
  if (QLDS) {
#pragma unroll
    for (int s = 0; s < NMAP * KS; ++s) *(bf16x8*)(qs + qoff + s * 32) = *(const bf16x8*)(qrow + 16 * s + 8 * h);
  } else {
#pragma unroll
    for (int s = 0; s < NMAP * KS; ++s) qf[QLDS ? 0 : s] = *(const bf16x8*)(qrow + 16 * s + 8 * h);
  }
  if (MODE == AT_MLA) {
    float x[6][8]; float ss = 0.f;
#pragma unroll
    for (int s = 0; s < 6; ++s) { const u32x4 u = __builtin_bit_cast(u32x4, qf[s]);
#pragma unroll
      for (int j = 0; j < 4; ++j) { x[s][2 * j] = bflo(u[j]); x[s][2 * j + 1] = bfhi(u[j]); } }
#pragma unroll
    for (int s = 0; s < 6; ++s)
#pragma unroll
      for (int j = 0; j < 8; ++j) ss += x[s][j] * x[s][j];
    ss += __shfl_xor(ss, 32);
    const float rr = rsqrtf(ss * (1.0f / 96.0f) + EPS);
    const float sc = 0.10206207261596577f * LOG2E;
#pragma unroll
    for (int s = 0; s < 6; ++s)
#pragma unroll
      for (int j = 0; j < 8; ++j) x[s][j] *= rr * a.g0[16 * s + 8 * h + j];
    const float* rt = a.rope + (size_t)posq * 32;
#pragma unroll
    for (int j = 0; j < 8; ++j) { const int i = 8 * h + j; const float c = rt[i], sn = rt[16 + i]; const float a0 = x[4][j], a1 = x[5][j]; x[4][j] = a0 * c - a1 * sn; x[5][j] = a1 * c + a0 * sn; }
#pragma unroll
    for (int s = 0; s < 6; ++s) { u32x4 u;
#pragma unroll
      for (int j = 0; j < 4; ++j) u[j] = pk2(x[s][2 * j] * sc, x[s][2 * j + 1] * sc);
      qf[s] = __builtin_bit_cast(bf16x8, u); }
  } else if (MODE == AT_XA) {
    float ss = 0.f;
#pragma unroll
    for (int s = 0; s < 16; ++s) ss = ssq8(qf[s], ss);
    ss += __shfl_xor(ss, 32);
    const float rr = rsqrtf(ss * (1.0f / 256.0f) + EPS) * 0.0625f * LOG2E;
#pragma unroll
    for (int s = 0; s < 16; ++s) { const u32x4 u = __builtin_bit_cast(u32x4, qf[s]); u32x4 w; const float* g = a.g0 + 16 * s + 8 * h;
#pragma unroll
      for (int j = 0; j < 4; ++j) w[j] = pk2(bflo(u[j]) * rr * g[2 * j], bfhi(u[j]) * rr * g[2 * j + 1]);
      qf[s] = __builtin_bit_cast(bf16x8, w); }
  }
  int kt_lo = 0, kt_hi = nkeys / KT;
  float slope2 = 0.f;
  if (MODE == AT_DIFF) {
    slope2 = exp2f(-(float)(head + 1)) * LOG2E;
    const int Wt = (int)((2.f * a.M + 32.f) / slope2) + 1;
    const int lo = pos0 - Wt, hi = pos0 + 256 + Wt;
    kt_lo = (lo > 0 ? lo : 0) / KT; const int hc = hi < S ? hi : S; kt_hi = (hc + KT - 1) / KT;
  }
#pragma nounroll
  for (int eh = 0; eh < (MODE == AT_XA ? 2 : 1); ++eh) {
  if (MODE == AT_XA && eh == 1) { vbase += 4096; orow += 128; }
  f32x16 oacc[NMAP][EB];
#pragma unroll
  for (int c = 0; c < NMAP; ++c)
#pragma unroll
    for (int e = 0; e < EB; ++e)
#pragma unroll
      for (int i = 0; i < 16; ++i) oacc[c][e][i] = 0.f;
  float lsum[NMAP];
#pragma unroll
  for (int c = 0; c < NMAP; ++c) lsum[c] = 0.f;
  const float negM = -a.M;
  u32x4 rk[NK_PER], rv[NV_PER];
#define AT_LOAD(k0_) do { const int k0 = (k0_); \
    _Pragma("unroll") for (int i = 0; i < NK_PER; ++i) { const int c = tid + NTHR * i, kk = c / CPR, kc = c % CPR; if (NCK % NTHR == 0 || c < NCK) rk[i] = *(const u32x4*)(kbase + (size_t)(k0 + kk) * kpitch + kc * 8); } \
    _Pragma("unroll") for (int i = 0; i < NV_PER; ++i) { const int c = tid + NTHR * i, e = c / VCPR, kc = c % VCPR; if (NCV % NTHR == 0 || c < NCV) rv[i] = (MODE == AT_MLA) ? *(const u32x4*)(vbase + (size_t)e * vpitch + k0 + kc * 8) : *(const u32x4*)(vbase + (size_t)(k0 >> 5) * vpitch + c * 8); } } while (0)
#define AT_WRITE(st_) do { unsigned char* ks_ = smem + (st_) * TILEB; unsigned char* vs_ = ks_ + KT * KP; \
    _Pragma("unroll") for (int i = 0; i < NK_PER; ++i) { const int c = tid + NTHR * i, kk = c / CPR, kc = c % CPR; const int pr = (kk & ~12) | ((kk & 4) << 1) | ((kk & 8) >> 1); if (NCK % NTHR == 0 || c < NCK) *(u32x4*)(ks_ + pr * KP + kc * 16) = rk[i]; } \
    _Pragma("unroll") for (int i = 0; i < NV_PER; ++i) { const int c = tid + NTHR * i, e = c / VCPR, kc = c % VCPR; if (NCV % NTHR == 0 || c < NCV) *(u32x4*)(vs_ + e * VP + kc * 16) = rv[i]; } } while (0)
  constexpr bool DBUF = (MODE != AT_XA);
  AT_LOAD(kt_lo * KT);
  if (DBUF) {
    AT_WRITE(0);
    if (kt_lo + 1 < kt_hi) AT_LOAD((kt_lo + 1) * KT);
    __syncthreads();
  }
  for (int kt = kt_lo; kt < kt_hi; ++kt) {
    const int cur = DBUF ? ((kt - kt_lo) & 1) : 0;
    const unsigned char* ks = smem + cur * TILEB; const unsigned char* vs = ks + KT * KP;
    if (DBUF) {
      if (kt + 1 < kt_hi) AT_WRITE(cur ^ 1);
      if (kt + 2 < kt_hi) AT_LOAD((kt + 2) * KT);
    } else {
      __syncthreads();
      AT_WRITE(0);
      __syncthreads();
      if (kt + 1 < kt_hi) AT_LOAD((kt + 1) * KT);
    }
    __builtin_amdgcn_sched_barrier(0);
#pragma unroll
    for (int kb = 0; kb < NKB; ++kb) {
      bf16x8 pf[NMAP][2];
      f32x16 cinit;
      if (MODE == AT_DIFF) {
        const float dbase = (float)(posq - kt * KT - 32 * kb - 8 * h);
#pragma unroll
        for (int i = 0; i < 16; ++i) { const float d = dbase - (float)(16 * (i >> 3) + (i & 7)); cinit[i] = fmaf(-slope2, fabsf(d), negM); }
      } else {
#pragma unroll
        for (int i = 0; i < 16; ++i) cinit[i] = negM;
      }
#pragma unroll
      for (int c = 0; c < NMAP; ++c) {
        f32x16 sacc;
#pragma unroll
        for (int s = 0; s < KS; ++s) {
          const bf16x8 kf = *(const bf16x8*)(ks + (32 * kb + r) * KP + (c * KS + s) * 32 + 16 * h);
          const bf16x8 qv = QLDS ? *(const bf16x8*)(qs + qoff + (c * KS + s) * 32) : qf[QLDS ? 0 : c * KS + s];
          sacc = (s == 0) ? MFMA(kf, qv, cinit) : MFMA(kf, qv, sacc);
        }
        float ls = 0.f;
#pragma unroll
        for (int i = 0; i < 16; ++i) { sacc[i] = __builtin_amdgcn_exp2f(sacc[i]); ls += sacc[i]; }
        lsum[c] += ls;
#pragma unroll
        for (int cc = 0; cc < 2; ++cc) { u32x4 u;
#pragma unroll
          for (int j = 0; j < 4; ++j) u[j] = pk2(sacc[8 * cc + 2 * j], sacc[8 * cc + 2 * j + 1]);
          pf[c][cc] = __builtin_bit_cast(bf16x8, u); }
      }
#pragma unroll
      for (int eb = 0; eb < EB; ++eb)
#pragma unroll
        for (int cc = 0; cc < 2; ++cc) {
          const bf16x8 vf = *(const bf16x8*)(vs + (eb * 32 + r) * VP + (32 * kb + 16 * cc + 8 * h) * 2);
#pragma unroll
          for (int c = 0; c < NMAP; ++c) oacc[c][eb] = MFMA(vf, pf[c][cc], oacc[c][eb]);
        }
    }
    if (DBUF) __syncthreads();
  }
#undef AT_LOAD
#undef AT_WRITE
  float inv[NMAP];
#pragma unroll
  for (int c = 0; c < NMAP; ++c) { float l = lsum[c]; l += __shfl_xor(l, 32); inv[c] = 1.0f / l; }
  if (MODE == AT_DIFF) {
    float ss = 0.f; const float l1 = a.lam * inv[NMAP - 1];
#pragma unroll
    for (int eb = 0; eb < EB; ++eb)
#pragma unroll
      for (int i = 0; i < 16; ++i) { const float v = oacc[0][eb][i] * inv[0] - oacc[NMAP - 1][eb][i] * l1; oacc[0][eb][i] = v; ss += v * v; }
    ss += __shfl_xor(ss, 32);
    const float rr = rsqrtf(ss * (1.0f / 128.0f) + EPS) * a.oscale;
#pragma unroll
    for (int eb = 0; eb < EB; ++eb)
#pragma unroll
      for (int g4 = 0; g4 < 4; ++g4) {
        const int e = eb * 32 + g4 * 8 + 4 * h; const f32x4 g = *(const f32x4*)(a.g0 + e);
        u32x2 w; w[0] = pk2(oacc[0][eb][4 * g4] * rr * g[0], oacc[0][eb][4 * g4 + 1] * rr * g[1]); w[1] = pk2(oacc[0][eb][4 * g4 + 2] * rr * g[2], oacc[0][eb][4 * g4 + 3] * rr * g[3]);
        if (!a.nostore) *(u32x2*)(orow + e) = w;
      }
  } else {
#pragma unroll
    for (int eb = 0; eb < EB; ++eb)
#pragma unroll
      for (int g4 = 0; g4 < 4; ++g4) {
        const int e = eb * 32 + g4 * 8 + 4 * h; const float iv = inv[0];
        u32x2 w; w[0] = pk2(oacc[0][eb][4 * g4] * iv, oacc[0][eb][4 * g4 + 1] * iv); w[1] = pk2(oacc[0][eb][4 * g4 + 2] * iv, oacc[0][eb][4 * g4 + 3] * iv);
        *(u32x2*)(orow + e) = w;
      }
  }
  }
}

DI void xa_unit(unsigned char* smem, const AttnArgs& a, int t0, int head) {
  constexpr int KP = 528;
  const int tid = my_tid(), lane = tid & 63, wid = tid >> 6, r = lane & 31, h = lane >> 5;
  const int tq = t0 + wid * 32 + r;
  const int seq = t0 < TP ? (t0 >> 13) : 8 + ((t0 - TP) >> 11);
  const bf16_t* kbase = a.K + (size_t)(seq * 256) * 1024 + head * 256;
  const bf16_t* vbase = a.VT + (size_t)(seq * 4 + head) * 65536;
  const bf16_t* qrow = a.Q + (size_t)tq * 1024 + head * 256; bf16_t* orow = a.O + (size_t)tq * 1024 + head * 256;
  {
    u32x4 rk[8];
#pragma unroll
    for (int rd = 0; rd < 2; ++rd) {
#pragma unroll
      for (int i = 0; i < 8; ++i) { const int c = tid + NTHR * (8 * rd + i), kk = c >> 5, kc = c & 31; rk[i] = *(const u32x4*)(kbase + (size_t)kk * 1024 + kc * 8); }
#pragma unroll
      for (int i = 0; i < 8; ++i) { const int c = tid + NTHR * (8 * rd + i), kk = c >> 5, kc = c & 31; const int pr = (kk & ~12) | ((kk & 4) << 1) | ((kk & 8) >> 1); *(u32x4*)(smem + pr * KP + kc * 16) = rk[i]; }
    }
  }
  bf16x8 qf[16];
#pragma unroll
  for (int s = 0; s < 16; ++s) qf[s] = *(const bf16x8*)(qrow + 16 * s + 8 * h);
  {
    float ss = 0.f;
#pragma unroll
    for (int s = 0; s < 16; ++s) ss = ssq8(qf[s], ss);
    ss += __shfl_xor(ss, 32);
    const float rr = rsqrtf(ss * (1.0f / 256.0f) + EPS) * 0.0625f * LOG2E;
#pragma unroll
    for (int s = 0; s < 16; ++s) { const u32x4 u = __builtin_bit_cast(u32x4, qf[s]); u32x4 w; const float* g = a.g0 + 16 * s + 8 * h;
#pragma unroll
      for (int j = 0; j < 4; ++j) w[j] = pk2(bflo(u[j]) * rr * g[2 * j], bfhi(u[j]) * rr * g[2 * j + 1]);
      qf[s] = __builtin_bit_cast(bf16x8, w); }
  }
  __syncthreads();
  u32x4 rvv[8];
#define XA_VLOAD(eh_) do { _Pragma("unroll") for (int i = 0; i < 8; ++i) rvv[i] = *(const u32x4*)(vbase + (size_t)(tid + NTHR * (2 * i + (eh_))) * 8); } while (0)
#define XA_VWRITE(eh_) do { _Pragma("unroll") for (int i = 0; i < 8; ++i) { const int c = tid + NTHR * (2 * i + (eh_)), kb = c >> 10, rem = c & 1023, e = rem >> 2, kc = rem & 3; *(u32x4*)(smem + e * KP + kb * 64 + kc * 16) = rvv[i]; } } while (0)
  XA_VLOAD(0);
  __builtin_amdgcn_sched_barrier(0);
  const float negM = -a.M;
  bf16x8 pfr[8][2];
  float lsum = 0.f;
#pragma unroll
  for (int kb = 0; kb < 8; ++kb) {
    f32x16 sacc;
#pragma unroll
    for (int i = 0; i < 16; ++i) sacc[i] = negM;
#pragma unroll
    for (int s = 0; s < 16; ++s) { const bf16x8 kf = *(const bf16x8*)(smem + (kb * 32 + r) * KP + s * 32 + 16 * h); sacc = MFMA(kf, qf[s], sacc); }
    float ls = 0.f;
#pragma unroll
    for (int i = 0; i < 16; ++i) { sacc[i] = __builtin_amdgcn_exp2f(sacc[i]); ls += sacc[i]; }
    lsum += ls;
#pragma unroll
    for (int cc = 0; cc < 2; ++cc) { u32x4 u;
#pragma unroll
      for (int j = 0; j < 4; ++j) u[j] = pk2(sacc[8 * cc + 2 * j], sacc[8 * cc + 2 * j + 1]);
      pfr[kb][cc] = __builtin_bit_cast(bf16x8, u); }
    __builtin_amdgcn_sched_barrier(0);
  }
  lsum += __shfl_xor(lsum, 32);
  const float inv = 1.0f / lsum;
  __syncthreads();
  XA_VWRITE(0);
  XA_VLOAD(1);
  __syncthreads();
#pragma unroll
  for (int eh = 0; eh < 2; ++eh) {
    if (eh == 1) { XA_VWRITE(1); __syncthreads(); }
    f32x16 oacc[4];
#pragma unroll
    for (int e = 0; e < 4; ++e)
#pragma unroll
      for (int i = 0; i < 16; ++i) oacc[e][i] = 0.f;
#pragma unroll
    for (int kb = 0; kb < 8; ++kb)
#pragma unroll
      for (int eb = 0; eb < 4; ++eb)
#pragma unroll
        for (int cc = 0; cc < 2; ++cc) {
          const bf16x8 vf = *(const bf16x8*)(smem + (eh * 128 + eb * 32 + r) * KP + (kb * 32 + 16 * cc + 8 * h) * 2);
          oacc[eb] = MFMA(vf, pfr[kb][cc], oacc[eb]);
        }
#pragma unroll
    for (int eb = 0; eb < 4; ++eb)
#pragma unroll
      for (int g4 = 0; g4 < 4; ++g4) {
        const int e = eh * 128 + eb * 32 + g4 * 8 + 4 * h;
        u32x2 w; w[0] = pk2(oacc[eb][4 * g4] * inv, oacc[eb][4 * g4 + 1] * inv); w[1] = pk2(oacc[eb][4 * g4 + 2] * inv, oacc[eb][4 * g4 + 3] * inv);
        *(u32x2*)(orow + e) = w;
      }
  }
#undef XA_VLOAD
#undef XA_VWRITE
}

template <int KS, int NMAP, int EB, int NKB, int MODE>
DI void attn_phase(unsigned char* smem, const AttnArgs& a, int* ctr) {
  int* s_unit = (int*)(smem + LDS_MAIN);
  constexpr int total = (MODE == AT_XA) ? 1536 : 3072;
  for (;;) {
    __syncthreads();
    if (my_tid() == 0) *s_unit = atomicAdd(ctr, 1);
    __syncthreads();
    const int u = *s_unit;
    if (u >= total) break;
    int head, qb, ehalf = 0;
    if (MODE == AT_XA) { head = u & 3; qb = u >> 2; }
    else if (MODE == AT_MLA) {
      if (u < 2048) { head = 7 - (u >> 8); qb = u & 255; } else { const int v = u - 2048; head = 7 - (v >> 7); qb = 256 + (v & 127); }
    }
    else { head = 7 - (u / 384); qb = u % 384; }
    if (MODE == AT_XA) xa_unit(smem, a, qb * 256, head);
    else attn_unit<KS, NMAP, EB, NKB, MODE>(smem, a, qb * 256, head, ehalf);
  }
}

DI void conv_fix(KargP p, int layer) {
  bf16_t* act = (bf16_t*)(p->ws + OFF_ACT);
  const bf16_t* gedge = (const bf16_t*)(p->ws + OFF_GEDGE); const bf16_t* uedge = (const bf16_t*)(p->ws + OFF_UEDGE);
  const float* cw = p->in[29] + (size_t)layer * 3 * 2816; const float* cb = p->in[30] + (size_t)layer * 2816;
  const int items = 384 * 2 * 704;
  for (int it = blockIdx.x * NTHR + my_tid(); it < items; it += gridDim.x * NTHR) {
    const int f = (it % 704) * 4, me = it / 704, e = me & 1, mt = me >> 1;
    const int t = mt * 256 + (e ? 255 : 0); int ss0, S; tok_info(t, ss0, S); const int pos = t - ss0;
    const bool has = e ? (pos + 1 < S) : (pos > 0);
    const u32x2 z = {0u, 0u};
    const u32x2 gm = e ? *(const u32x2*)(gedge + (size_t)(mt * 4 + 2) * 2816 + f) : (has ? *(const u32x2*)(gedge + (size_t)((mt - 1) * 4 + 3) * 2816 + f) : z);
    const u32x2 gc = *(const u32x2*)(gedge + (size_t)(mt * 4 + (e ? 3 : 0)) * 2816 + f);
    const u32x2 gp = e ? (has ? *(const u32x2*)(gedge + (size_t)((mt + 1) * 4 + 0) * 2816 + f) : z) : *(const u32x2*)(gedge + (size_t)(mt * 4 + 1) * 2816 + f);
    const f32x4 w0 = *(const f32x4*)(cw + f), w1 = *(const f32x4*)(cw + 2816 + f), w2 = *(const f32x4*)(cw + 5632 + f), bb = *(const f32x4*)(cb + f);
    const u32x2 ub = *(const u32x2*)(uedge + (size_t)me * 2816 + f);
    const f32x4 u = {bflo(ub[0]), bfhi(ub[0]), bflo(ub[1]), bfhi(ub[1])};
    f32x4 v;
    v[0] = w0[0] * bflo(gm[0]) + w1[0] * bflo(gc[0]) + w2[0] * bflo(gp[0]) + bb[0];
    v[1] = w0[1] * bfhi(gm[0]) + w1[1] * bfhi(gc[0]) + w2[1] * bfhi(gp[0]) + bb[1];
    v[2] = w0[2] * bflo(gm[1]) + w1[2] * bflo(gc[1]) + w2[2] * bflo(gp[1]) + bb[2];
    v[3] = w0[3] * bfhi(gm[1]) + w1[3] * bfhi(gc[1]) + w2[3] * bfhi(gp[1]) + bb[3];
    u32x2 w;
    w[0] = pk2(v[0] / (1.f + __expf(-v[0])) * u[0], v[1] / (1.f + __expf(-v[1])) * u[1]);
    w[1] = pk2(v[2] / (1.f + __expf(-v[2])) * u[2], v[3] / (1.f + __expf(-v[3])) * u[3]);
    *(u32x2*)(act + (size_t)t * 2816 + f) = w;
  }
}

DI void run_phase(KargP p, int ph, unsigned char* smem) {
  unsigned char* ws = p->ws;
  bf16_t* R = (bf16_t*)(ws + OFF_R);
  bf16_t* xb = (bf16_t*)(ws + OFF_XB);
  const float* cf = (const float*)(ws + OFF_CONSTS);
  int* ctr = (int*)(ws + OFF_CONSTS + 256);
  const float* rope = (const float*)(ws + OFF_ROPE);
  EpiArgs ea{};
  if (ph == 0) { phase_prep(p, smem); return; }
  if (ph == 1) {
    for (int l = 0; l < 4; ++l) {
      ea.o0 = (bf16_t*)(ws + OFF_MEMK) + (size_t)l * NMEMT * 1024; ea.o1 = (bf16_t*)(ws + OFF_MEMVT) + (size_t)l * NMEMT * 1024;
      gemm_phase<EPI_MEMKV, false>(smem, (const bf16_t*)(ws + OFF_MEMB), 1024, (const bf16_t*)(ws + OFF_W_XA_KV) + (size_t)l * 2048 * 1024, 1024, 0, NMEMT / 256, 8, ea);
    }
  }
  int q = ph - 1, layer = 0;
  for (;;) { const int n = (layer & 1) ? 9 : 10; if (q < n) break; q -= n; ++layer; }
  const int j = layer >> 1;
  const int nm = (layer & 1) ? 3 : 4;
  if (q < nm) {
    if (!(layer & 1)) {
      bf16_t* Qb = R; bf16_t* Kb = R + (size_t)T * 768; bf16_t* VTb = R + (size_t)T * 1536; bf16_t* Cb = R + (size_t)T * 2048; bf16_t* Ob = Cb;
      if (q == 0) {
        ea.o0 = Cb; ea.ldc = 672; ea.nvalid = 672;
        gemm_phase<EPI_PLAIN, true>(smem, xb, 1024, (const bf16_t*)(ws + OFF_W_MLA_DOWN) + (size_t)j * 768 * 1024, 1024, 0, T / 256, 3, ea);
      } else if (q == 1) {
        if (layer == 0) memk_norm(p);
        ea.o0 = Qb; ea.ldc = 768; ea.nvalid = 768;
        gemm_phase<EPI_PLAIN, true>(smem, Cb, 672, (const bf16_t*)(ws + OFF_W_MLA_UQ) + (size_t)j * 768 * 384, 384, 0, T / 256, 3, ea);
        EpiArgs eb{}; eb.o0 = Kb; eb.o1 = VTb; eb.g0 = p->in[11] + j * 96; eb.aux = Cb; eb.rope = rope;
        gemm_phase<EPI_MLAKV, true>(smem, Cb + 384, 672, (const bf16_t*)(ws + OFF_W_MLA_UKV) + (size_t)j * 1024 * 256, 256, 0, T / 256, 4, eb);
      } else if (q == 2) {
        AttnArgs a{}; a.Q = Qb; a.K = Kb; a.VT = VTb; a.O = Ob; a.g0 = p->in[10] + j * 96; a.rope = rope; a.M = cf[j];
        for (int rp = 0; rp < REP_MLA; ++rp) attn_phase<6, 1, 2, 2, AT_MLA>(smem, a, ctr + layer * 2 + 16 * rp);
      } else {
        ea.XB = xb;
        gemm_phase<EPI_RES, false>(smem, Ob, 512, (const bf16_t*)(ws + OFF_W_MLA_WO) + (size_t)j * 1024 * 512, 512, 0, T / 256, 4, ea);
      }
    } else {
      bf16_t* Qb = R; bf16_t* Kb = R + (size_t)T * 1024; bf16_t* VTb = R + (size_t)T * 2048;
      if (q == 0) {
        ea.o0 = Qb; ea.o1 = Kb; ea.o2 = VTb; ea.g0 = p->in[15] + j * 128; ea.g1 = p->in[16] + j * 128;
        gemm_phase<EPI_DIFFQKV, true>(smem, xb, 1024, (const bf16_t*)(ws + OFF_W_DIFF_QKV) + (size_t)j * 3072 * 1024, 1024, 0, T / 256, 12, ea);
      } else if (q == 1) {
        const float linit = 0.8f - 0.6f * expf(-0.3f * (float)layer);
        AttnArgs a{}; a.Q = Qb; a.K = Kb; a.VT = VTb; a.O = Qb; a.g0 = p->in[18] + j * 128; a.M = cf[2 + j]; a.lam = cf[4 + j]; a.oscale = 1.f - linit;
        for (int rp = 0; rp < REP_DIFF; ++rp) { int ns = (rp + 1 < REP_DIFF); asm volatile("" : "+s"(ns)); a.nostore = ns; attn_phase<4, 2, 4, 1, AT_DIFF>(smem, a, ctr + layer * 2 + 16 * rp); }
      } else {
        ea.XB = xb;
        gemm_phase<EPI_RES, false>(smem, Qb, 1024, (const bf16_t*)(ws + OFF_W_DIFF_WO) + (size_t)j * 1024 * 1024, 1024, 0, T / 256, 4, ea);
      }
    }
    return;
  }
  q -= nm;
  if (q < 3) {
    bf16_t* XQ = R; bf16_t* XO = R + (size_t)T * 1024;
    if (q == 0) {
      ea.o0 = XQ; ea.ldc = 1024; ea.nvalid = 1024;
      gemm_phase<EPI_PLAIN, true>(smem, xb, 1024, (const bf16_t*)(ws + OFF_W_XA_Q) + (size_t)layer * 1024 * 1024, 1024, 0, T / 256, 4, ea);
    } else if (q == 1) {
      AttnArgs a{}; a.Q = XQ; a.K = (const bf16_t*)(ws + OFF_MEMK) + (size_t)layer * NMEMT * 1024; a.VT = (const bf16_t*)(ws + OFF_MEMVT) + (size_t)layer * NMEMT * 1024; a.O = XO;
      a.g0 = p->in[24] + layer * 256; a.M = cf[6 + layer];
      for (int rp = 0; rp < REP_XA; ++rp) attn_phase<16, 1, 4, 1, AT_XA>(smem, a, ctr + layer * 2 + 1 + 16 * rp);
    } else {
      ea.XB = xb;
      gemm_phase<EPI_RES, false>(smem, XO, 1024, (const bf16_t*)(ws + OFF_W_XA_O) + (size_t)layer * 1024 * 1024, 1024, 0, T / 256, 4, ea);
    }
    return;
  }
  q -= 3;
  {
    bf16_t* act = (bf16_t*)(ws + OFF_ACT);
    if (q == 0) {
      ea.o0 = act; ea.cw = p->in[29] + (size_t)layer * 3 * 2816; ea.cb = p->in[30] + (size_t)layer * 2816;
      ea.gedge = (bf16_t*)(ws + OFF_GEDGE); ea.uedge = (bf16_t*)(ws + OFF_UEDGE);
      gemm_phase<EPI_GUCONV, true>(smem, xb, 1024, (const bf16_t*)(ws + OFF_W_FFN_GU) + (size_t)layer * 5632 * 1024, 1024, 0, T / 256, 22, ea);
    } else if (q == 1) {
      conv_fix(p, layer);
    } else {
      ea.XB = xb; if (layer == 3) ea.X = p->out;
      gemm_phase<EPI_RES, false>(smem, act, 2816, (const bf16_t*)(ws + OFF_W_FFN_DOWN) + (size_t)layer * 1024 * 2816, 2816, 0, T / 256, 4, ea);
    }
  }
}

DI void grid_barrier(unsigned* xb, unsigned xcc, unsigned n_x, unsigned nxcd, unsigned k) {
  asm volatile("s_waitcnt vmcnt(0)" ::: "memory");
  __syncthreads();
  if (my_tid() == 0) {
    const unsigned old = __hip_atomic_fetch_add(xb + 1024 + 64 * xcc, 1u, __ATOMIC_RELAXED, __HIP_MEMORY_SCOPE_AGENT);
    if (old + 1u == n_x * k) {
      __builtin_amdgcn_fence(__ATOMIC_RELEASE, "agent");
      asm volatile("s_waitcnt vmcnt(0)" ::: "memory");
      __hip_atomic_fetch_add(xb + 2048, 1u, __ATOMIC_RELAXED, __HIP_MEMORY_SCOPE_AGENT);
    }
    while (__hip_atomic_load(xb + 2048, __ATOMIC_RELAXED, __HIP_MEMORY_SCOPE_AGENT) < nxcd * k) __builtin_amdgcn_s_sleep(2);
    __builtin_amdgcn_fence(__ATOMIC_ACQUIRE, "agent");
    asm volatile("s_waitcnt vmcnt(0)" ::: "memory");
  }
  __syncthreads();
}

#if MULTI_LAUNCH
__global__ void __launch_bounds__(NTHR, 2) k_phase(P p, int ph) {
  extern __shared__ __attribute__((aligned(16))) unsigned char smem[];
  run_phase(get_kargs(), ph, smem);
}
#else
__global__ void __launch_bounds__(NTHR, 2) k_mega(P p) {
  extern __shared__ __attribute__((aligned(16))) unsigned char smem[];
  cg::grid_group grid = cg::this_grid();
  unsigned* xbw = (unsigned*)(get_kargs()->ws + OFF_XBAR);
  const unsigned xcc = (unsigned)__builtin_amdgcn_s_getreg((3 << 11) | 20) & 0xFu;
  if (my_tid() == 0) __hip_atomic_fetch_add(xbw + 64 * xcc, 1u, __ATOMIC_RELAXED, __HIP_MEMORY_SCOPE_AGENT);
  phase_prep(get_kargs(), smem);
  grid.sync();
  unsigned n_x = __hip_atomic_load(xbw + 64 * xcc, __ATOMIC_RELAXED, __HIP_MEMORY_SCOPE_AGENT), nxcd = 0;
  for (int j = 0; j < 16; ++j) nxcd += __hip_atomic_load(xbw + 64 * j, __ATOMIC_RELAXED, __HIP_MEMORY_SCOPE_AGENT) != 0u ? 1u : 0u;
  n_x = __builtin_amdgcn_readfirstlane(n_x); nxcd = __builtin_amdgcn_readfirstlane(nxcd);
#pragma nounroll
  for (int ph = 1; ph < NPHASE; ++ph) {
    KargP pp = get_kargs();
    run_phase(pp, ph, smem);
    if (ph + 1 < NPHASE) grid_barrier(xbw, xcc, n_x, nxcd, (unsigned)ph);
  }
}
#endif

extern "C" void kernel_launch(void* const* d_in, const int* in_sizes, int n_in, void* d_out, int out_size, void* d_ws, size_t ws_size, hipStream_t stream) {
  static int grid_blocks = 0;
#if MULTI_LAUNCH
  const void* kfn = (const void*)k_phase;
#else
  const void* kfn = (const void*)k_mega;
#endif
  if (!grid_blocks) {
    if (n_in != 32 || ws_size < WS_NEED) { fprintf(stderr, "kernel_launch: unexpected n_in %d or ws_size %zu (< %zu)\n", n_in, ws_size, (size_t)WS_NEED); grid_blocks = -1; return; }
    int dev = 0, cus = 0, per_cu = 0;
    hipGetDevice(&dev);
    hipDeviceGetAttribute(&cus, hipDeviceAttributeMultiprocessorCount, dev);
    hipFuncSetAttribute(kfn, hipFuncAttributeMaxDynamicSharedMemorySize, LDS_BYTES);
    hipOccupancyMaxActiveBlocksPerMultiprocessor(&per_cu, kfn, NTHR, LDS_BYTES);
    if (per_cu < 1) per_cu = 1;
    if (per_cu > 1) per_cu = 1;
    grid_blocks = cus * per_cu;
    fprintf(stderr, "kernel_launch: grid %d (%d CUs x %d)\n", grid_blocks, cus, per_cu);
  }
  if (grid_blocks < 0) return;
  P hp{};
  for (int i = 0; i < 32; ++i) hp.in[i] = (const float*)d_in[i];
  hp.out = (float*)d_out; hp.ws = (unsigned char*)d_ws;
#if MULTI_LAUNCH
  for (int ph = 0; ph < NPHASE; ++ph) hipLaunchKernelGGL(k_phase, dim3(grid_blocks), dim3(NTHR), LDS_BYTES, stream, hp, ph);
#else
  if (hipMemsetAsync((unsigned char*)d_ws + OFF_XBAR, 0, 16384, stream) != hipSuccess) { fprintf(stderr, "kernel_launch: hipMemsetAsync of the barrier word failed\n"); return; }
  void* args[] = {&hp};
  hipError_t e = hipLaunchCooperativeKernel(kfn, dim3(grid_blocks), dim3(NTHR), args, LDS_BYTES, stream);
  if (e != hipSuccess) fprintf(stderr, "cooperative launch failed: %s (grid %d)\n", hipGetErrorString(e), grid_blocks);
#endif
}
```

```cpp
#include <hip/hip_runtime.h>
#include <hip/hip_cooperative_groups.h>
#include <cstdio>
#include <cstdint>
namespace cg = cooperative_groups;

#ifndef REP_GU
#define REP_GU 1
#endif
#ifndef REP_MLA
#define REP_MLA 1
#endif
#ifndef REP_DIFF
#define REP_DIFF 1
#endif
#ifndef REP_XA
#define REP_XA 1
#endif
#ifndef MULTI_LAUNCH
#define MULTI_LAUNCH 0
#endif

typedef unsigned short bf16_t;
typedef short bf16x8 __attribute__((ext_vector_type(8)));
typedef float f32x16 __attribute__((ext_vector_type(16)));
typedef float f32x4 __attribute__((ext_vector_type(4)));
typedef unsigned u32x4 __attribute__((ext_vector_type(4)));
typedef unsigned u32x2 __attribute__((ext_vector_type(2)));
typedef __bf16 bf2_t __attribute__((ext_vector_type(2)));
#define DI __device__ __forceinline__
#define MFMA(a, b, c) __builtin_amdgcn_mfma_f32_32x32x16_bf16((a), (b), (c), 0, 0, 0)

constexpr int TP = 65536, TS = 32768, T = 98304, NMEMT = 6144;
constexpr int HALF_T = 49152;
constexpr float EPS = 1e-6f;
constexpr float LOG2E = 1.4426950408889634f;
constexpr int NTHR = 512, NW = 8;
constexpr int LDS_MAIN = 147456;
constexpr int LDS_BYTES = LDS_MAIN + 16;
constexpr int NPHASE = 39;

constexpr size_t OFF_W_MLA_DOWN = 0;
constexpr size_t OFF_W_MLA_UQ   = OFF_W_MLA_DOWN + 2ull * 768 * 1024 * 2;
constexpr size_t OFF_W_MLA_UKV  = OFF_W_MLA_UQ + 2ull * 768 * 384 * 2;
constexpr size_t OFF_W_MLA_WO   = OFF_W_MLA_UKV + 2ull * 1024 * 256 * 2;
constexpr size_t OFF_W_DIFF_QKV = OFF_W_MLA_WO + 2ull * 1024 * 512 * 2;
constexpr size_t OFF_W_DIFF_WO  = OFF_W_DIFF_QKV + 2ull * 3072 * 1024 * 2;
constexpr size_t OFF_W_XA_Q     = OFF_W_DIFF_WO + 2ull * 1024 * 1024 * 2;
constexpr size_t OFF_W_XA_KV    = OFF_W_XA_Q + 4ull * 1024 * 1024 * 2;
constexpr size_t OFF_W_XA_O     = OFF_W_XA_KV + 4ull * 2048 * 1024 * 2;
constexpr size_t OFF_W_FFN_GU   = OFF_W_XA_O + 4ull * 1024 * 1024 * 2;
constexpr size_t OFF_W_FFN_DOWN = OFF_W_FFN_GU + 4ull * 5632 * 1024 * 2;
constexpr size_t OFF_CONSTS     = OFF_W_FFN_DOWN + 4ull * 1024 * 2816 * 2;
constexpr size_t OFF_BAR        = OFF_CONSTS + 2048;
constexpr size_t OFF_ROPE       = OFF_CONSTS + 4096;
constexpr size_t OFF_XB         = OFF_ROPE + 8192ull * 32 * 4;
constexpr size_t OFF_MEMB       = OFF_XB + (size_t)T * 1024 * 2;
constexpr size_t OFF_MEMK       = OFF_MEMB + (size_t)NMEMT * 1024 * 2;
constexpr size_t OFF_MEMVT      = OFF_MEMK + 4ull * NMEMT * 1024 * 2;
constexpr size_t OFF_R          = OFF_MEMVT + 4ull * NMEMT * 1024 * 2;
constexpr size_t WS_END         = OFF_R + (size_t)T * 3072 * 2;
constexpr size_t OFF_XBAR       = WS_END;
constexpr size_t WS_NEED        = WS_END + 16384;
constexpr size_t OFF_ACT = OFF_R, OFF_GEDGE = OFF_ACT + (size_t)T * 2816 * 2, OFF_UEDGE = OFF_GEDGE + 384ull * 4 * 2816 * 2;
static_assert(OFF_UEDGE + 384ull * 2 * 2816 * 4 <= WS_END, "FFN overlay");

struct P { const float* in[32]; float* out; unsigned char* ws; };
typedef const P __attribute__((address_space(4)))* KargP;
__device__ __forceinline__ KargP get_kargs() {
#if defined(__HIP_DEVICE_COMPILE__)
  KargP pp = (KargP)__builtin_amdgcn_kernarg_segment_ptr();
  asm volatile("" : "+s"(pp));
  return pp;
#else
  return nullptr;
#endif
}

struct PrepJob { int src, L, K, N, Npad, gsrc; unsigned long long dst; };
__constant__ PrepJob JOBS[11] = {
  {5, 2, 1024, 672, 768, 4, OFF_W_MLA_DOWN},
  {8, 2, 384, 768, 768, 6, OFF_W_MLA_UQ},
  {9, 2, 256, 1024, 1024, 7, OFF_W_MLA_UKV},
  {12, 2, 512, 1024, 1024, -1, OFF_W_MLA_WO},
  {14, 2, 1024, 3072, 3072, 13, OFF_W_DIFF_QKV},
  {19, 2, 1024, 1024, 1024, -1, OFF_W_DIFF_WO},
  {22, 4, 1024, 1024, 1024, 20, OFF_W_XA_Q},
  {23, 4, 1024, 2048, 2048, 21, OFF_W_XA_KV},
  {26, 4, 1024, 1024, 1024, -1, OFF_W_XA_O},
  {28, 4, 1024, 5632, 5632, 27, OFF_W_FFN_GU},
  {31, 4, 2816, 1024, 1024, -1, OFF_W_FFN_DOWN},
};

DI int my_tid() { int t = threadIdx.x; asm volatile("" : "+v"(t)); return t; }
DI unsigned pk2(float a, float b) { bf2_t v; v[0] = (__bf16)a; v[1] = (__bf16)b; return __builtin_bit_cast(unsigned, v); }
DI float bflo(unsigned u) { return __uint_as_float(u << 16); }
DI float bfhi(unsigned u) { return __uint_as_float(u & 0xffff0000u); }
DI float dot2s(unsigned u, float c) { bf2_t v = __builtin_bit_cast(bf2_t, u); return __builtin_amdgcn_fdot2_f32_bf16(v, v, c, false); }
DI float ssq8(bf16x8 x, float c) { u32x4 u = __builtin_bit_cast(u32x4, x); c = dot2s(u[0], c); c = dot2s(u[1], c); c = dot2s(u[2], c); c = dot2s(u[3], c); return c; }
DI void tok_info(int t, int& seq_start, int& S) { if (t < TP) { seq_start = t & ~8191; S = 8192; } else { seq_start = TP + ((t - TP) & ~2047); S = 2048; } }
DI void st_bf16(bf16_t* p, float v) { *p = (bf16_t)(pk2(v, 0.f) & 0xffffu); }

DI void phase_prep(KargP p, unsigned char* smem) {
  const int tid = my_tid();
  {
    float* tile = (float*)smem;
    int total = 0;
    for (int j = 0; j < 11; ++j) total += JOBS[j].L * (JOBS[j].K / 64) * (JOBS[j].Npad / 64);
    const int tx4 = tid & 15, ty4 = tid >> 4;
    float v[8], vn[8];
    bf16_t* dst = nullptr; int dK = 0; bf16_t* dstn = nullptr; int dKn = 0;
#define PREP_LOAD(TIX, V, DST, DK) do { int j = 0, rem = (TIX); \
      for (;;) { const int n_ = JOBS[j].L * (JOBS[j].K / 64) * (JOBS[j].Npad / 64); if (rem < n_) break; rem -= n_; ++j; } \
      const int K = JOBS[j].K, N = JOBS[j].N, Npad = JOBS[j].Npad, nkt = K / 64, nnt = Npad / 64; \
      const int l = rem / (nkt * nnt); rem -= l * nkt * nnt; \
      const int kt = rem / nnt, nt = rem % nnt, k0 = kt * 64, n0 = nt * 64; \
      const float* W = p->in[JOBS[j].src] + (size_t)l * K * N; \
      const float* g = JOBS[j].gsrc >= 0 ? p->in[JOBS[j].gsrc] + (size_t)l * K : nullptr; \
      int n = n0 + 4 * tx4; \
      if (j == 9) { const int jb = n0 >> 8, w = n0 & 255; n = (w < 128 ? jb * 128 + w : 2816 + jb * 128 + (w - 128)) + 4 * tx4; }     \
      _Pragma("unroll") for (int q = 0; q < 2; ++q) { const int kk = ty4 + 32 * q; f32x4 x = {0.f, 0.f, 0.f, 0.f}; if (n < N) x = __builtin_nontemporal_load((const f32x4*)(W + (size_t)(k0 + kk) * N + n));     \
        const float gk = g ? g[k0 + kk] : 1.f; V[4 * q] = x[0] * gk; V[4 * q + 1] = x[1] * gk; V[4 * q + 2] = x[2] * gk; V[4 * q + 3] = x[3] * gk; } \
      DST = (bf16_t*)(p->ws + JOBS[j].dst) + (size_t)l * Npad * K + (size_t)n0 * K + k0; DK = K; } while (0)
    int tix = blockIdx.x;
    if (tix < total) PREP_LOAD(tix, v, dst, dK);
    for (; tix < total; tix += gridDim.x) {
      const int nx = tix + gridDim.x;
      if (nx < total) PREP_LOAD(nx, vn, dstn, dKn);
      __syncthreads();
#pragma unroll
      for (int q = 0; q < 2; ++q)
#pragma unroll
        for (int jj = 0; jj < 4; ++jj) tile[(ty4 + 32 * q) * 65 + 4 * tx4 + jj] = v[4 * q + jj];
      __syncthreads();
      const int kp = (tid & 15) * 4, nb = tid >> 4;
#pragma unroll
      for (int jn = 0; jn < 2; ++jn) {
        const int nn = nb + 32 * jn;
        u32x2 w; w[0] = pk2(tile[kp * 65 + nn], tile[(kp + 1) * 65 + nn]); w[1] = pk2(tile[(kp + 2) * 65 + nn], tile[(kp + 3) * 65 + nn]);
        *(u32x2*)(dst + (size_t)nn * dK + kp) = w;
      }
#pragma unroll
      for (int q = 0; q < 8; ++q) v[q] = vn[q];
      dst = dstn; dK = dKn;
    }
#undef PREP_LOAD
  }
  const int lane = tid & 63, gw = blockIdx.x * NW + (tid >> 6), nw = gridDim.x * NW;
  {
    bf16_t* xb = (bf16_t*)(p->ws + OFF_XB);
    for (int row = gw; row < T; row += 2 * nw) {
      const int row2 = row + nw < T ? row + nw : row;
      const float* src = row < TP ? p->in[0] + (size_t)row * 1024 : p->in[1] + (size_t)(row - TP) * 1024;
      const float* src2 = row2 < TP ? p->in[0] + (size_t)row2 * 1024 : p->in[1] + (size_t)(row2 - TP) * 1024;
      f32x4 va[4], vb[4];
#pragma unroll
      for (int i = 0; i < 4; ++i) { va[i] = __builtin_nontemporal_load((const f32x4*)(src + lane * 4 + 256 * i)); vb[i] = __builtin_nontemporal_load((const f32x4*)(src2 + lane * 4 + 256 * i)); }
#pragma unroll
      for (int i = 0; i < 4; ++i) {
        const int c = lane * 4 + 256 * i;
        u32x2 w; w[0] = pk2(va[i][0], va[i][1]); w[1] = pk2(va[i][2], va[i][3]);
        *(u32x2*)(xb + (size_t)row * 1024 + c) = w;
        u32x2 w2; w2[0] = pk2(vb[i][0], vb[i][1]); w2[1] = pk2(vb[i][2], vb[i][3]);
        *(u32x2*)(xb + (size_t)row2 * 1024 + c) = w2;
      }
    }
  }
  {
    bf16_t* mb = (bf16_t*)(p->ws + OFF_MEMB);
    for (int row = gw; row < NMEMT; row += nw) {
      const float* src = row < 2048 ? p->in[2] + (size_t)row * 1024 : p->in[3] + (size_t)(row - 2048) * 1024;
      f32x4 v[4]; float ss = 0.f;
#pragma unroll
      for (int i = 0; i < 4; ++i) { v[i] = *(const f32x4*)(src + lane * 4 + 256 * i); ss += v[i][0] * v[i][0] + v[i][1] * v[i][1] + v[i][2] * v[i][2] + v[i][3] * v[i][3]; }
#pragma unroll
      for (int m = 1; m < 64; m <<= 1) ss += __shfl_xor(ss, m);
      const float rs = rsqrtf(ss * (1.0f / 1024.0f) + EPS);
#pragma unroll
      for (int i = 0; i < 4; ++i) { u32x2 w; w[0] = pk2(v[i][0] * rs, v[i][1] * rs); w[1] = pk2(v[i][2] * rs, v[i][3] * rs); *(u32x2*)(mb + (size_t)row * 1024 + lane * 4 + 256 * i) = w; }
    }
  }
  {
    float* rt = (float*)(p->ws + OFF_ROPE);
    for (int idx = blockIdx.x * NTHR + tid; idx < 8192 * 16; idx += gridDim.x * NTHR) {
      const int pos = idx >> 4, i = idx & 15;
      const float inv = powf(10000.0f, -(float)i / 16.0f);
      const float ang = (float)pos * inv;
      float s, c; sincosf(ang, &s, &c);
      rt[pos * 32 + i] = c; rt[pos * 32 + 16 + i] = s;
    }
  }
  if (blockIdx.x == 0) {
    float* cf = (float*)(p->ws + OFF_CONSTS);
    int* ctr = (int*)(p->ws + OFF_CONSTS + 256);
    if (tid < 64) ctr[tid] = 0;
    const int wid = tid >> 6;
    auto absmax = [&](const float* g, int n) { float m = 0.f; for (int i = lane; i < n; i += 64) m = fmaxf(m, fabsf(g[i])); for (int s = 1; s < 64; s <<= 1) m = fmaxf(m, __shfl_xor(m, s)); return m; };
    if (wid == 0) {
      for (int j = 0; j < 2; ++j) {
        const float mq = absmax(p->in[10] + j * 96, 96), mk = absmax(p->in[11] + j * 96, 96);
        const float M = 96.f * mq * mk * 0.10206207261596577f * LOG2E * 1.03f + 0.25f;
        if (lane == 0) cf[j] = M;
      }
    } else if (wid == 1) {
      for (int j = 0; j < 2; ++j) {
        const float mq = absmax(p->in[15] + j * 128, 128), mk = absmax(p->in[16] + j * 128, 128);
        const float M = 64.f * mq * mk * 0.125f * LOG2E * 1.03f + 0.25f;
        if (lane == 0) cf[2 + j] = M;
      }
    } else if (wid == 2) {
      for (int j = 0; j < 2; ++j) {
        const float* lp = p->in[17] + j * 256;
        float a = lp[lane] * lp[64 + lane], b = lp[128 + lane] * lp[192 + lane];
        for (int s = 1; s < 64; s <<= 1) { a += __shfl_xor(a, s); b += __shfl_xor(b, s); }
        const float linit = 0.8f - 0.6f * expf(-0.3f * (float)(2 * j + 1));
        if (lane == 0) cf[4 + j] = expf(a) - expf(b) + linit;
      }
    } else if (wid == 3) {
      for (int i = 0; i < 4; ++i) {
        const float mq = absmax(p->in[24] + i * 256, 256), mk = absmax(p->in[25] + i * 256, 256);
        const float M = 256.f * mq * mk * 0.0625f * LOG2E * 1.03f + 0.25f;
        if (lane == 0) cf[6 + i] = M;
      }
    }
  }
}

DI void memk_norm(KargP p) {
  const int tid = my_tid(), lane = tid & 63, gw = blockIdx.x * NW + (tid >> 6), nw = gridDim.x * NW;
  bf16_t* mk = (bf16_t*)(p->ws + OFF_MEMK);
  for (int row = gw; row < 4 * NMEMT * 4; row += nw) {
    const int l = row / (NMEMT * 4);
    bf16_t* ptr = mk + (size_t)row * 256 + lane * 4;
    const u32x2 u = *(const u32x2*)ptr;
    float x0 = bflo(u[0]), x1 = bfhi(u[0]), x2 = bflo(u[1]), x3 = bfhi(u[1]);
    float ss = x0 * x0 + x1 * x1 + x2 * x2 + x3 * x3;
#pragma unroll
    for (int m = 1; m < 64; m <<= 1) ss += __shfl_xor(ss, m);
    const float rs = rsqrtf(ss * (1.0f / 256.0f) + EPS);
    const f32x4 g = *(const f32x4*)(p->in[25] + l * 256 + lane * 4);
    u32x2 w; w[0] = pk2(x0 * rs * g[0], x1 * rs * g[1]); w[1] = pk2(x2 * rs * g[2], x3 * rs * g[3]);
    *(u32x2*)ptr = w;
  }
}

enum { EPI_PLAIN = 0, EPI_RES = 1, EPI_MLAKV = 2, EPI_DIFFQKV = 3, EPI_MEMKV = 4, EPI_GUCONV = 5 };
struct EpiArgs {
  bf16_t* o0; bf16_t* o1; bf16_t* o2; int ldc; int nvalid;
  float* X; bf16_t* XB;
  const float* g0; const float* g1; const bf16_t* aux; const float* rope; int nostore;
  const float* cw; const float* cb; bf16_t* gedge; bf16_t* uedge;
};

template <int EPI, bool RS>
DI void gemm_epilogue(unsigned char* smem, f32x16 (&acc)[2][4], const float (&ssq)[4], int K, int m0, int nt256, const EpiArgs& ea, int wt, int wf, int r, int h) {
  asm volatile("" : "+v"(r), "+v"(h));
  const int nt = nt256 * 2 + (wf >> 1), wc = wf & 1;
  const int n0 = nt * 128;
  float rstd[4] = {1.f, 1.f, 1.f, 1.f};
  if (RS) {
#pragma unroll
    for (int tb = 0; tb < 4; ++tb) { float s = ssq[tb]; s += __shfl_xor(s, 32); rstd[tb] = rsqrtf(s / (float)K + EPS); }
  }
  if (EPI == EPI_PLAIN) {
#pragma unroll
    for (int tb = 0; tb < 4; ++tb) {
      const int tok = m0 + wt * 128 + tb * 32 + r; const float rs = rstd[tb];
      bf16_t* rowp = ea.o0 + (size_t)tok * ea.ldc;
#pragma unroll
      for (int fb = 0; fb < 2; ++fb)
#pragma unroll
        for (int g4 = 0; g4 < 4; ++g4) {
          const int col = n0 + wc * 64 + fb * 32 + g4 * 8 + 4 * h;
          if (col < ea.nvalid && !ea.nostore) { u32x2 w; w[0] = pk2(acc[fb][tb][4 * g4] * rs, acc[fb][tb][4 * g4 + 1] * rs); w[1] = pk2(acc[fb][tb][4 * g4 + 2] * rs, acc[fb][tb][4 * g4 + 3] * rs); *(u32x2*)(rowp + col) = w; }
        }
    }
  } else if (EPI == EPI_RES) {
    unsigned char* es = smem + 73728;
    constexpr int EP = 528;
    const int tid = ((wt * 4 + wf) * 2 + h) * 32 + r;
#pragma unroll
    for (int hf = 0; hf < 2; ++hf) {
      if (wt == hf) {
#pragma unroll
        for (int tb = 0; tb < 4; ++tb)
#pragma unroll
          for (int fb = 0; fb < 2; ++fb)
#pragma unroll
            for (int g4 = 0; g4 < 4; ++g4) {
              u32x2 w; w[0] = pk2(acc[fb][tb][4 * g4], acc[fb][tb][4 * g4 + 1]); w[1] = pk2(acc[fb][tb][4 * g4 + 2], acc[fb][tb][4 * g4 + 3]);
              *(u32x2*)(es + (tb * 32 + r) * EP + (wf * 64 + fb * 32 + g4 * 8 + 4 * h) * 2) = w;
            }
      }
      __syncthreads();
#pragma unroll
      for (int i = 0; i < 8; ++i) {
        const int c = tid + NTHR * i, row = c >> 5, kc = c & 31;
        const u32x4 d = *(const u32x4*)(es + row * EP + kc * 16);
        const size_t off = (size_t)(m0 + hf * 128 + row) * 1024 + nt256 * 256 + kc * 8;
        const u32x4 xo = *(const u32x4*)(ea.XB + off);
        float xn[8];
#pragma unroll
        for (int j = 0; j < 4; ++j) { xn[2 * j] = bflo(xo[j]) + bflo(d[j]); xn[2 * j + 1] = bfhi(xo[j]) + bfhi(d[j]); }
        if (ea.X) {
          f32x4 o0 = {xn[0], xn[1], xn[2], xn[3]}, o1 = {xn[4], xn[5], xn[6], xn[7]};
          __builtin_nontemporal_store(o0, (f32x4*)(ea.X + off)); __builtin_nontemporal_store(o1, (f32x4*)(ea.X + off + 4));
        } else {
          u32x4 w;
#pragma unroll
          for (int j = 0; j < 4; ++j) w[j] = pk2(xn[2 * j], xn[2 * j + 1]);
          *(u32x4*)(ea.XB + off) = w;
        }
      }
      __syncthreads();
    }
  } else if (EPI == EPI_MLAKV) {
    const int head = nt;
    if (wc == 0) {
#pragma unroll
      for (int tb = 0; tb < 4; ++tb) {
        const int tok = m0 + wt * 128 + tb * 32 + r; int ss0, S; tok_info(tok, ss0, S); const int pos = tok - ss0;
        const float a = rstd[tb]; float ss = 0.f;
#pragma unroll
        for (int fb = 0; fb < 2; ++fb)
#pragma unroll
          for (int i = 0; i < 16; ++i) { const float v = acc[fb][tb][i] * a; acc[fb][tb][i] = v; ss += v * v; }
        const bf16_t* cr = ea.aux + (size_t)tok * 672 + 640;
        {
          const u32x4 r0 = *(const u32x4*)(cr + 8 * h), r1 = *(const u32x4*)(cr + 16 + 8 * h);
#pragma unroll
          for (int j = 0; j < 4; ++j) { ss = dot2s(r0[j], ss); ss = dot2s(r1[j], ss); }
        }
        ss += __shfl_xor(ss, 32);
        const float rr = rsqrtf(ss * (1.0f / 96.0f) + EPS);
        bf16_t* ko = ea.o0 + (size_t)tok * 768 + head * 96;
#pragma unroll
        for (int fb = 0; fb < 2; ++fb)
#pragma unroll
          for (int g4 = 0; g4 < 4; ++g4) {
            const int d = fb * 32 + g4 * 8 + 4 * h;
            const f32x4 g = *(const f32x4*)(ea.g0 + d);
            u32x2 w; w[0] = pk2(acc[fb][tb][4 * g4] * rr * g[0], acc[fb][tb][4 * g4 + 1] * rr * g[1]); w[1] = pk2(acc[fb][tb][4 * g4 + 2] * rr * g[2], acc[fb][tb][4 * g4 + 3] * rr * g[3]);
            *(u32x2*)(ko + d) = w;
          }
        __builtin_amdgcn_sched_barrier(0);
        asm volatile("" : "+v"(cr));
        const u32x4 r0 = *(const u32x4*)(cr + 8 * h), r1 = *(const u32x4*)(cr + 16 + 8 * h);
        float x0[8], x1[8];
#pragma unroll
        for (int j = 0; j < 4; ++j) { x0[2 * j] = bflo(r0[j]); x0[2 * j + 1] = bfhi(r0[j]); x1[2 * j] = bflo(r1[j]); x1[2 * j + 1] = bfhi(r1[j]); }
        const float* rt = ea.rope + (size_t)pos * 32;
        float y0[8], y1[8];
#pragma unroll
        for (int j = 0; j < 8; ++j) {
          const int i = 8 * h + j; const float c = rt[i], s = rt[16 + i];
          const float a0 = x0[j] * rr * ea.g0[64 + i], a1 = x1[j] * rr * ea.g0[80 + i];
          y0[j] = a0 * c - a1 * s; y1[j] = a1 * c + a0 * s;
        }
        u32x4 w0, w1;
#pragma unroll
        for (int j = 0; j < 4; ++j) { w0[j] = pk2(y0[2 * j], y0[2 * j + 1]); w1[j] = pk2(y1[2 * j], y1[2 * j + 1]); }
        *(u32x4*)(ko + 64 + 8 * h) = w0; *(u32x4*)(ko + 80 + 8 * h) = w1;
        __builtin_amdgcn_sched_barrier(0);
      }
    } else {
#pragma unroll
      for (int tb = 0; tb < 4; ++tb) {
        const int tok = m0 + wt * 128 + tb * 32 + r; int ss0, S; tok_info(tok, ss0, S); const int pos = tok - ss0;
        const float a = rstd[tb];
        const unsigned vb = ((unsigned)ss0 * 512u + (unsigned)(head * 64 + 4 * h) * (unsigned)S + (unsigned)pos) * 2u, eS = (unsigned)S * 2u;
#pragma unroll
        for (int fb = 0; fb < 2; ++fb)
#pragma unroll
          for (int i = 0; i < 16; ++i) { const unsigned e = fb * 32 + 8 * (i >> 2) + (i & 3); st_bf16((bf16_t*)((char*)ea.o1 + (vb + e * eS)), acc[fb][tb][i] * a); }
      }
    }
  } else if (EPI == EPI_DIFFQKV) {
    const int sec = nt >> 3, head = nt & 7;
    if (sec < 2) {
      const float* g = (sec == 0 ? ea.g0 : ea.g1) + wc * 64; const float sc = sec == 0 ? 0.125f * LOG2E : 1.f; bf16_t* ob = sec == 0 ? ea.o0 : ea.o1;
#pragma unroll
      for (int tb = 0; tb < 4; ++tb) {
        const int tok = m0 + wt * 128 + tb * 32 + r; const float a = rstd[tb]; float ss = 0.f;
#pragma unroll
        for (int fb = 0; fb < 2; ++fb)
#pragma unroll
          for (int i = 0; i < 16; ++i) { const float v = acc[fb][tb][i] * a; acc[fb][tb][i] = v; ss += v * v; }
        ss += __shfl_xor(ss, 32);
        const float rr = rsqrtf(ss * (1.0f / 64.0f) + EPS) * sc;
        bf16_t* op = ob + (size_t)tok * 1024 + head * 128 + wc * 64;
#pragma unroll
        for (int fb = 0; fb < 2; ++fb)
#pragma unroll
          for (int g4 = 0; g4 < 4; ++g4) {
            const int d = fb * 32 + g4 * 8 + 4 * h;
            const f32x4 gg = *(const f32x4*)(g + d);
            u32x2 w; w[0] = pk2(acc[fb][tb][4 * g4] * rr * gg[0], acc[fb][tb][4 * g4 + 1] * rr * gg[1]); w[1] = pk2(acc[fb][tb][4 * g4 + 2] * rr * gg[2], acc[fb][tb][4 * g4 + 3] * rr * gg[3]);
            *(u32x2*)(op + d) = w;
          }
      }
    } else {
#pragma unroll
      for (int tb = 0; tb < 4; ++tb) {
        const int tok = m0 + wt * 128 + tb * 32 + r; int ss0, S; tok_info(tok, ss0, S); const int pos = tok - ss0;
        const float a = rstd[tb];
        const unsigned vb = ((unsigned)ss0 * 1024u + (unsigned)(head * 128) * (unsigned)S + (unsigned)(pos >> 5) * 4096u + (unsigned)(wc * 64 + 4 * h) * 32u + (unsigned)(pos & 31)) * 2u, eS = 64u;
#pragma unroll
        for (int fb = 0; fb < 2; ++fb)
#pragma unroll
          for (int i = 0; i < 16; ++i) { const unsigned e = fb * 32 + 8 * (i >> 2) + (i & 3); st_bf16((bf16_t*)((char*)ea.o2 + (vb + e * eS)), acc[fb][tb][i] * a); }
      }
    }
  } else if (EPI == EPI_MEMKV) {
    if (nt < 8) {
#pragma unroll
      for (int tb = 0; tb < 4; ++tb) {
        const int tok = m0 + wt * 128 + tb * 32 + r;
        bf16_t* rowp = ea.o0 + (size_t)tok * 1024 + n0 + wc * 64;
#pragma unroll
        for (int fb = 0; fb < 2; ++fb)
#pragma unroll
          for (int g4 = 0; g4 < 4; ++g4) {
            u32x2 w; w[0] = pk2(acc[fb][tb][4 * g4], acc[fb][tb][4 * g4 + 1]); w[1] = pk2(acc[fb][tb][4 * g4 + 2], acc[fb][tb][4 * g4 + 3]);
            *(u32x2*)(rowp + fb * 32 + g4 * 8 + 4 * h) = w;
          }
      }
    } else {
      const int cbase = (nt - 8) * 128 + wc * 64, head = cbase >> 8, e0 = cbase & 255;
#pragma unroll
      for (int tb = 0; tb < 4; ++tb) {
        const int tok = m0 + wt * 128 + tb * 32 + r, seq = tok >> 8, key = tok & 255;
        const unsigned vb = ((((unsigned)(seq * 4 + head) * 8u + (unsigned)(key >> 5)) * 256u + (unsigned)(e0 + 4 * h)) * 32u + (unsigned)(key & 31)) * 2u;
#pragma unroll
        for (int fb = 0; fb < 2; ++fb)
#pragma unroll
          for (int i = 0; i < 16; ++i) { const unsigned e = fb * 32 + 8 * (i >> 2) + (i & 3); st_bf16((bf16_t*)((char*)ea.o1 + (vb + e * 64u)), acc[fb][tb][i]); }
      }
    }
  }
  if (EPI == EPI_GUCONV) {
    constexpr int GP = 272;
    const int fw = (wf & 1) * 64, jb = nt256, mt = m0 >> 8;
    {
      unsigned char* dst = smem + (wf < 2 ? 0 : 73728);
#pragma unroll
      for (int tb = 0; tb < 4; ++tb) {
        const int rr = wt * 128 + tb * 32 + r; const float rs = rstd[tb];
#pragma unroll
        for (int fb = 0; fb < 2; ++fb)
#pragma unroll
          for (int g4 = 0; g4 < 4; ++g4) {
            const int f = fw + fb * 32 + g4 * 8 + 4 * h;
            u32x2 w; w[0] = pk2(acc[fb][tb][4 * g4] * rs, acc[fb][tb][4 * g4 + 1] * rs); w[1] = pk2(acc[fb][tb][4 * g4 + 2] * rs, acc[fb][tb][4 * g4 + 3] * rs);
            *(u32x2*)(dst + rr * GP + f * 2) = w;
          }
      }
    }
    __syncthreads();
    {
      const unsigned char* gs_ = smem; const unsigned char* us_ = smem + 73728;
      const int tid = ((wt * 4 + wf) * 2 + h) * 32 + r, kc = tid & 15, r0 = tid >> 4, fg = jb * 128 + kc * 8;
      float w0[8], w1[8], w2[8], bb[8];
#pragma unroll
      for (int q4 = 0; q4 < 2; ++q4) {
        const f32x4 a0 = *(const f32x4*)(ea.cw + fg + 4 * q4), a1 = *(const f32x4*)(ea.cw + 2816 + fg + 4 * q4), a2 = *(const f32x4*)(ea.cw + 5632 + fg + 4 * q4), a3 = *(const f32x4*)(ea.cb + fg + 4 * q4);
#pragma unroll
        for (int j = 0; j < 4; ++j) { w0[4 * q4 + j] = a0[j]; w1[4 * q4 + j] = a1[j]; w2[4 * q4 + j] = a2[j]; bb[4 * q4 + j] = a3[j]; }
      }
#pragma unroll
      for (int i = 0; i < 8; ++i) {
        const int row = r0 + 32 * i;
        const int rm = (i == 0 && row == 0) ? 0 : row - 1, rp = (i == 7 && row == 255) ? 255 : row + 1;
        u32x4 gm = *(const u32x4*)(gs_ + rm * GP + kc * 16);
        const u32x4 gc = *(const u32x4*)(gs_ + row * GP + kc * 16);
        u32x4 gp = *(const u32x4*)(gs_ + rp * GP + kc * 16);
        const u32x4 uu = *(const u32x4*)(us_ + row * GP + kc * 16);
        if (i == 0) { const bool z = row == 0;
#pragma unroll
          for (int j = 0; j < 4; ++j) gm[j] = z ? 0u : gm[j]; }
        if (i == 7) { const bool z = row == 255;
#pragma unroll
          for (int j = 0; j < 4; ++j) gp[j] = z ? 0u : gp[j]; }
        u32x4 o;
#pragma unroll
        for (int j = 0; j < 4; ++j) {
          const float a0 = w0[2 * j] * bflo(gm[j]) + w1[2 * j] * bflo(gc[j]) + w2[2 * j] * bflo(gp[j]) + bb[2 * j];
          const float a1 = w0[2 * j + 1] * bfhi(gm[j]) + w1[2 * j + 1] * bfhi(gc[j]) + w2[2 * j + 1] * bfhi(gp[j]) + bb[2 * j + 1];
          const float s0 = a0 * __builtin_amdgcn_rcpf(1.f + __builtin_amdgcn_exp2f(-LOG2E * a0)), s1 = a1 * __builtin_amdgcn_rcpf(1.f + __builtin_amdgcn_exp2f(-LOG2E * a1));
          o[j] = pk2(s0 * bflo(uu[j]), s1 * bfhi(uu[j]));
        }
        __builtin_nontemporal_store(o, (u32x4*)(ea.o0 + (size_t)(m0 + row) * 2816 + fg));
        if (i == 0 && row < 2) { *(u32x4*)(ea.gedge + (size_t)(mt * 4 + row) * 2816 + fg) = gc; if (row == 0) *(u32x4*)(ea.uedge + (size_t)(mt * 2) * 2816 + fg) = uu; }
        if (i == 7 && row >= 254) { *(u32x4*)(ea.gedge + (size_t)(mt * 4 + row - 252) * 2816 + fg) = gc; if (row == 255) *(u32x4*)(ea.uedge + (size_t)(mt * 2 + 1) * 2816 + fg) = uu; }
      }
    }
    __syncthreads();
  }
}

DI void map_tile(int L, int nMt, int nNt, int& pm, int& pn) {
  const int total = nMt * nNt, q = total >> 3, rr = total & 7, xcd = L & 7, off = L >> 3;
  const int wg = (xcd < rr ? xcd * (q + 1) : rr * (q + 1) + (xcd - rr) * q) + off;
  constexpr int WGM = 8;
  const int nig = WGM * nNt, gid = wg / nig, fm = gid * WGM, gsz = (nMt - fm) < WGM ? (nMt - fm) : WGM;
  pm = fm + (wg % nig) % gsz; pn = (wg % nig) / gsz;
}

template <int EPI, bool RS>
DI void gemm_phase(unsigned char* smem, const bf16_t* __restrict__ A, int lda, const bf16_t* __restrict__ Bt, int K, int mt0, int nMt, int nNt, const EpiArgs& ea) {
  const int total = nMt * nNt;
  int tile = blockIdx.x;
  if (tile >= total) return;
  const int tid = my_tid(), lane = tid & 63, wid = tid >> 6, wt = wid >> 2, wf = wid & 3, r = lane & 31, h = lane >> 5;
  const int srow = tid >> 3, skc = tid & 7;
  const size_t astep = (size_t)128 * lda, bstep = (size_t)128 * K;
  const unsigned voffA = (unsigned)(srow * lda + skc * 8) * 2u, voffB = (unsigned)(srow * K + skc * 8) * 2u;
  const unsigned swoff = srow * 144 + skc * 16;
  const unsigned aoff = (wt * 128 + r) * 144 + h * 16, boff = 36864 + (wf * 64 + r) * 144 + h * 16;
  const int nk = K >> 6;
  constexpr bool DEEP = (EPI == EPI_PLAIN || EPI == EPI_RES || EPI == EPI_MEMKV);
  u32x4 rg[8], rh[DEEP ? 8 : 1];
#define G_LD2R(R, i, PA, PB) do { R[i] = *(const u32x4*)((PA) + (i) * astep + voffA); R[4 + (i)] = *(const u32x4*)((PB) + (i) * bstep + voffB); } while (0)
#define G_LD2(i, PA, PB) G_LD2R(rg, i, PA, PB)
#define G_WR2R(R, i, st) do { unsigned char* sw_ = smem + (st) * 73728 + swoff + (i) * 9216; *(u32x4*)(sw_) = R[i]; *(u32x4*)(sw_ + 36864) = R[4 + (i)]; } while (0)
#define G_WR2(i, st) G_WR2R(rg, i, st)
#define G_FRAGS(F, sb, s) do { F[0] = *(const bf16x8*)((sb) + boff + (s) * 32); F[1] = *(const bf16x8*)((sb) + boff + 4608 + (s) * 32); \
    _Pragma("unroll") for (int t_ = 0; t_ < 4; ++t_) F[2 + t_] = *(const bf16x8*)((sb) + aoff + t_ * 4608 + (s) * 32); } while (0)
#define G_MMA(F) do { if (RS) { _Pragma("unroll") for (int t_ = 0; t_ < 4; ++t_) ssq[t_] = ssq8(F[2 + t_], ssq[t_]); } \
    _Pragma("unroll") for (int t_ = 0; t_ < 4; ++t_) { acc[0][t_] = MFMA(F[0], F[2 + t_], acc[0][t_]); acc[1][t_] = MFMA(F[1], F[2 + t_], acc[1][t_]); } } while (0)
#define SB() __builtin_amdgcn_sched_barrier(0)
  int nt, mtl; map_tile(tile, nMt, nNt, mtl, nt);
  int m0 = (mt0 + mtl) * 256;
  const char* ga = (const char*)(A + (size_t)m0 * lda);
  const char* gb = (const char*)(Bt + (size_t)(nt * 256) * K);
  constexpr bool XPF = (EPI != EPI_MLAKV && EPI != EPI_GUCONV);
  constexpr bool XPR = (EPI == EPI_GUCONV);
  bf16x8 fa[6];
  bool first = true;
  for (;;) {
    if (!XPF || first) {
      if (!XPR || first) {
#pragma unroll
        for (int i = 0; i < 4; ++i) G_LD2(i, ga, gb);
      }
#pragma unroll
      for (int i = 0; i < 4; ++i) G_WR2(i, 0);
#pragma unroll
      for (int i = 0; i < 4; ++i) G_LD2(i, ga + 128, gb + 128);
      if (DEEP) {
#pragma unroll
        for (int i = 0; i < 4; ++i) G_LD2R(rh, i, ga + 256, gb + 256);
      }
      __syncthreads();
      first = false;
      G_FRAGS(fa, smem, 0);
    }
    const int ntile = tile + gridDim.x;
    const bool has_next = ntile < total;
    int nt_n = nt, m0_n = m0;
    if (has_next) { int pm_, pn_; map_tile(ntile, nMt, nNt, pm_, pn_); nt_n = pn_; m0_n = (mt0 + pm_) * 256; }
    const char* ga_n = (const char*)(A + (size_t)m0_n * lda);
    const char* gb_n = (const char*)(Bt + (size_t)(nt_n * 256) * K);
    f32x16 acc[2][4];
#pragma unroll
    for (int a = 0; a < 2; ++a)
#pragma unroll
      for (int b = 0; b < 4; ++b)
#pragma unroll
        for (int i = 0; i < 16; ++i) acc[a][b][i] = 0.f;
    float ssq[4] = {0.f, 0.f, 0.f, 0.f};
#define G_BODY(R, kt_, PA, PB) do { const unsigned char* sb_ = smem + ((kt_) & 1) * 73728; const unsigned char* sn_ = smem + (((kt_) + 1) & 1) * 73728; const int wst = ((kt_) + 1) & 1; \
        G_MMA(fa); SB(); G_WR2R(R, 0, wst); G_LD2R(R, 0, PA, PB); G_WR2R(R, 1, wst); G_LD2R(R, 1, PA, PB); G_FRAGS(fa, sb_, 1); SB(); \
        G_MMA(fa); SB(); G_WR2R(R, 2, wst); G_LD2R(R, 2, PA, PB); G_WR2R(R, 3, wst); G_LD2R(R, 3, PA, PB); G_FRAGS(fa, sb_, 2); SB(); \
        G_MMA(fa); SB(); G_FRAGS(fa, sb_, 3); SB(); \
        __syncthreads(); \
        G_MMA(fa); SB(); G_FRAGS(fa, sn_, 0); SB(); } while (0)
    if (DEEP) {
#define G_ITER(R, kt_) do { const int k3 = (kt_) + 3; \
        const char* pa = k3 < nk ? ga + k3 * 128 : ga_n + (k3 - nk) * 128; const char* pb = k3 < nk ? gb + k3 * 128 : gb_n + (k3 - nk) * 128; \
        G_BODY(R, kt_, pa, pb); } while (0)
      for (int kt = 0; kt < nk; kt += 2) { G_ITER(rg, kt); G_ITER(rh, kt + 1); }
#undef G_ITER
    } else {
      for (int kt = 0; kt < (XPR ? nk - 1 : nk); ++kt) {
        const int k2 = kt + 2;
        const char* pa = k2 < nk ? ga + k2 * 128 : ((XPF || XPR) ? ga_n + (k2 - nk) * 128 : ga);
        const char* pb = k2 < nk ? gb + k2 * 128 : ((XPF || XPR) ? gb_n + (k2 - nk) * 128 : gb);
        G_BODY(rg, kt, pa, pb);
      }
      if (XPR) {
        const unsigned char* sb_ = smem + 73728;
        G_MMA(fa); SB(); G_FRAGS(fa, sb_, 1); SB();
        G_MMA(fa); SB(); G_FRAGS(fa, sb_, 2); SB();
        G_MMA(fa); SB(); G_FRAGS(fa, sb_, 3); SB();
        __syncthreads();
        G_MMA(fa); SB();
      }
    }
#undef G_BODY
    gemm_epilogue<EPI, RS>(smem, acc, ssq, K, m0, nt, ea, wt, wf, r, h);
    if (!has_next) break;
    tile = ntile; nt = nt_n; m0 = m0_n; ga = ga_n; gb = gb_n;
  }
#undef G_LD2
#undef G_WR2
#undef G_LD2R
#undef G_WR2R
#undef G_FRAGS
#undef G_MMA
#undef SB
}

enum { AT_MLA = 0, AT_DIFF = 1, AT_XA = 2 };
struct AttnArgs {
  const bf16_t* Q; const bf16_t* K; const bf16_t* VT; bf16_t* O;
  const float* g0; const float* g1; const float* rope;
  float M; float lam; float oscale; int nostore;
};

template <int KS, int NMAP, int EB, int NKB, int MODE>
DI void attn_unit(unsigned char* smem, const AttnArgs& a, int t0, int head, int ehalf) {
  constexpr int DK = KS * 16 * NMAP, KP = DK * 2 + 16, KT = 32 * NKB, VP = KT * 2 + 16;
  constexpr int CPR = DK / 8, NCK = KT * CPR, NK_PER = (NCK + NTHR - 1) / NTHR, VCPR = KT / 8, NCV = EB * 32 * VCPR, NV_PER = (NCV + NTHR - 1) / NTHR;
  const int tid = my_tid(), lane = tid & 63, wid = tid >> 6, r = lane & 31, h = lane >> 5;
  constexpr int TILEB = KT * KP + EB * 32 * VP;
  int seq_start, S; tok_info(t0, seq_start, S);
  const int pos0 = t0 - seq_start;
  const int tq = t0 + wid * 32 + r, posq = pos0 + wid * 32 + r;
  const bf16_t* kbase; const bf16_t* vbase; size_t vpitch; int kpitch, nkeys; const bf16_t* qrow; bf16_t* orow;
  if (MODE == AT_MLA) {
    kpitch = 768; kbase = a.K + (size_t)seq_start * 768 + head * 96; vpitch = S; vbase = a.VT + (size_t)seq_start * 512 + (size_t)(head * 64) * S; nkeys = S;
    qrow = a.Q + (size_t)tq * 768 + head * 96; orow = a.O + (size_t)tq * 512 + head * 64;
  } else if (MODE == AT_DIFF) {
    kpitch = 1024; kbase = a.K + (size_t)seq_start * 1024 + head * 128; vpitch = 4096; vbase = a.VT + (size_t)seq_start * 1024 + (size_t)(head * 128) * S; nkeys = S;
    qrow = a.Q + (size_t)tq * 1024 + head * 128; orow = a.O + (size_t)tq * 1024 + head * 128;
  } else {
    const int seq = t0 < TP ? (t0 >> 13) : 8 + ((t0 - TP) >> 11);
    kpitch = 1024; kbase = a.K + (size_t)(seq * 256) * 1024 + head * 256; vpitch = 8192; vbase = a.VT + (size_t)(seq * 4 + head) * 65536 + ehalf * 4096; nkeys = 256;
    qrow = a.Q + (size_t)tq * 1024 + head * 256; orow = a.O + (size_t)tq * 1024 + head * 256 + ehalf * 128;
  }
  constexpr bool QLDS = (MODE == AT_DIFF);
  unsigned char* qs = smem + 2 * TILEB;
  const unsigned qoff = (wid * 32 + r) * KP + 16 * h;
  bf16x8 qf[QLDS ? 1 : NMAP * KS];
  if (QLDS) {
#pragma unroll
    for (int s = 0; s < NMAP * KS; ++s) *(bf16x8*)(qs + qoff + s * 32) = *(const bf16x8*)(qrow + 16 * s + 8 * h);
  } else {
#pragma unroll
    for (int s = 0; s < NMAP * KS; ++s) qf[QLDS ? 0 : s] = *(const bf16x8*)(qrow + 16 * s + 8 * h);
  }
  if (MODE == AT_MLA) {
    float x[6][8]; float ss = 0.f;
#pragma unroll
    for (int s = 0; s < 6; ++s) { const u32x4 u = __builtin_bit_cast(u32x4, qf[s]);
#pragma unroll
      for (int j = 0; j < 4; ++j) { x[s][2 * j] = bflo(u[j]); x[s][2 * j + 1] = bfhi(u[j]); } }
#pragma unroll
    for (int s = 0; s < 6; ++s)
#pragma unroll
      for (int j = 0; j < 8; ++j) ss += x[s][j] * x[s][j];
    ss += __shfl_xor(ss, 32);
    const float rr = rsqrtf(ss * (1.0f / 96.0f) + EPS);
    const float sc = 0.10206207261596577f * LOG2E;
#pragma unroll
    for (int s = 0; s < 6; ++s)
#pragma unroll
      for (int j = 0; j < 8; ++j) x[s][j] *= rr * a.g0[16 * s + 8 * h + j];
    const float* rt = a.rope + (size_t)posq * 32;
#pragma unroll
    for (int j = 0; j < 8; ++j) { const int i = 8 * h + j; const float c = rt[i], sn = rt[16 + i]; const float a0 = x[4][j], a1 = x[5][j]; x[4][j] = a0 * c - a1 * sn; x[5][j] = a1 * c + a0 * sn; }
#pragma unroll
    for (int s = 0; s < 6; ++s) { u32x4 u;
#pragma unroll
      for (int j = 0; j < 4; ++j) u[j] = pk2(x[s][2 * j] * sc, x[s][2 * j + 1] * sc);
      qf[s] = __builtin_bit_cast(bf16x8, u); }
  } else if (MODE == AT_XA) {
    float ss = 0.f;
#pragma unroll
    for (int s = 0; s < 16; ++s) ss = ssq8(qf[s], ss);
    ss += __shfl_xor(ss, 32);
    const float rr = rsqrtf(ss * (1.0f / 256.0f) + EPS) * 0.0625f * LOG2E;
#pragma unroll
    for (int s = 0; s < 16; ++s) { const u32x4 u = __builtin_bit_cast(u32x4, qf[s]); u32x4 w; const float* g = a.g0 + 16 * s + 8 * h;
#pragma unroll
      for (int j = 0; j < 4; ++j) w[j] = pk2(bflo(u[j]) * rr * g[2 * j], bfhi(u[j]) * rr * g[2 * j + 1]);
      qf[s] = __builtin_bit_cast(bf16x8, w); }
  }
  int kt_lo = 0, kt_hi = nkeys / KT;
  float slope2 = 0.f;
  if (MODE == AT_DIFF) {
    slope2 = exp2f(-(float)(head + 1)) * LOG2E;
    const int Wt = (int)((2.f * a.M + 32.f) / slope2) + 1;
    const int lo = pos0 - Wt, hi = pos0 + 256 + Wt;
    kt_lo = (lo > 0 ? lo : 0) / KT; const int hc = hi < S ? hi : S; kt_hi = (hc + KT - 1) / KT;
  }
#pragma nounroll
  for (int eh = 0; eh < (MODE == AT_XA ? 2 : 1); ++eh) {
  if (MODE == AT_XA && eh == 1) { vbase += 4096; orow += 128; }
  f32x16 oacc[NMAP][EB];
#pragma unroll
  for (int c = 0; c < NMAP; ++c)
#pragma unroll
    for (int e = 0; e < EB; ++e)
#pragma unroll
      for (int i = 0; i < 16; ++i) oacc[c][e][i] = 0.f;
  float lsum[NMAP];
#pragma unroll
  for (int c = 0; c < NMAP; ++c) lsum[c] = 0.f;
  const float negM = -a.M;
  u32x4 rk[NK_PER], rv[NV_PER];
#define AT_LOAD(k0_) do { const int k0 = (k0_); \
    _Pragma("unroll") for (int i = 0; i < NK_PER; ++i) { const int c = tid + NTHR * i, kk = c / CPR, kc = c % CPR; if (NCK % NTHR == 0 || c < NCK) rk[i] = *(const u32x4*)(kbase + (size_t)(k0 + kk) * kpitch + kc * 8); } \
    _Pragma("unroll") for (int i = 0; i < NV_PER; ++i) { const int c = tid + NTHR * i, e = c / VCPR, kc = c % VCPR; if (NCV % NTHR == 0 || c < NCV) rv[i] = (MODE == AT_MLA) ? *(const u32x4*)(vbase + (size_t)e * vpitch + k0 + kc * 8) : *(const u32x4*)(vbase + (size_t)(k0 >> 5) * vpitch + c * 8); } } while (0)
#define AT_WRITE(st_) do { unsigned char* ks_ = smem + (st_) * TILEB; unsigned char* vs_ = ks_ + KT * KP; \
    _Pragma("unroll") for (int i = 0; i < NK_PER; ++i) { const int c = tid + NTHR * i, kk = c / CPR, kc = c % CPR; const int pr = (kk & ~12) | ((kk & 4) << 1) | ((kk & 8) >> 1); if (NCK % NTHR == 0 || c < NCK) *(u32x4*)(ks_ + pr * KP + kc * 16) = rk[i]; } \
    _Pragma("unroll") for (int i = 0; i < NV_PER; ++i) { const int c = tid + NTHR * i, e = c / VCPR, kc = c % VCPR; if (NCV % NTHR == 0 || c < NCV) *(u32x4*)(vs_ + e * VP + kc * 16) = rv[i]; } } while (0)
  constexpr bool DBUF = (MODE != AT_XA);
  AT_LOAD(kt_lo * KT);
  if (DBUF) {
    AT_WRITE(0);
    if (kt_lo + 1 < kt_hi) AT_LOAD((kt_lo + 1) * KT);
    __syncthreads();
  }
  for (int kt = kt_lo; kt < kt_hi; ++kt) {
    const int cur = DBUF ? ((kt - kt_lo) & 1) : 0;
    const unsigned char* ks = smem + cur * TILEB; const unsigned char* vs = ks + KT * KP;
    if (DBUF) {
      if (kt + 1 < kt_hi) AT_WRITE(cur ^ 1);
      if (kt + 2 < kt_hi) AT_LOAD((kt + 2) * KT);
    } else {
      __syncthreads();
      AT_WRITE(0);
      __syncthreads();
      if (kt + 1 < kt_hi) AT_LOAD((kt + 1) * KT);
    }
    __builtin_amdgcn_sched_barrier(0);
#pragma unroll
    for (int kb = 0; kb < NKB; ++kb) {
      bf16x8 pf[NMAP][2];
      f32x16 cinit;
      if (MODE == AT_DIFF) {
        const float dbase = (float)(posq - kt * KT - 32 * kb - 8 * h);
#pragma unroll
        for (int i = 0; i < 16; ++i) { const float d = dbase - (float)(16 * (i >> 3) + (i & 7)); cinit[i] = fmaf(-slope2, fabsf(d), negM); }
      } else {
#pragma unroll
        for (int i = 0; i < 16; ++i) cinit[i] = negM;
      }
#pragma unroll
      for (int c = 0; c < NMAP; ++c) {
        f32x16 sacc;
#pragma unroll
        for (int s = 0; s < KS; ++s) {
          const bf16x8 kf = *(const bf16x8*)(ks + (32 * kb + r) * KP + (c * KS + s) * 32 + 16 * h);
          const bf16x8 qv = QLDS ? *(const bf16x8*)(qs + qoff + (c * KS + s) * 32) : qf[QLDS ? 0 : c * KS + s];
          sacc = (s == 0) ? MFMA(kf, qv, cinit) : MFMA(kf, qv, sacc);
        }
        float ls = 0.f;
#pragma unroll
        for (int i = 0; i < 16; ++i) { sacc[i] = __builtin_amdgcn_exp2f(sacc[i]); ls += sacc[i]; }
        lsum[c] += ls;
#pragma unroll
        for (int cc = 0; cc < 2; ++cc) { u32x4 u;
#pragma unroll
          for (int j = 0; j < 4; ++j) u[j] = pk2(sacc[8 * cc + 2 * j], sacc[8 * cc + 2 * j + 1]);
          pf[c][cc] = __builtin_bit_cast(bf16x8, u); }
      }
#pragma unroll
      for (int eb = 0; eb < EB; ++eb)
#pragma unroll
        for (int cc = 0; cc < 2; ++cc) {
          const bf16x8 vf = *(const bf16x8*)(vs + (eb * 32 + r) * VP + (32 * kb + 16 * cc + 8 * h) * 2);
#pragma unroll
          for (int c = 0; c < NMAP; ++c) oacc[c][eb] = MFMA(vf, pf[c][cc], oacc[c][eb]);
        }
    }
    if (DBUF) __syncthreads();
  }
#undef AT_LOAD
#undef AT_WRITE
  float inv[NMAP];
#pragma unroll
  for (int c = 0; c < NMAP; ++c) { float l = lsum[c]; l += __shfl_xor(l, 32); inv[c] = 1.0f / l; }
  if (MODE == AT_DIFF) {
    float ss = 0.f; const float l1 = a.lam * inv[NMAP - 1];
#pragma unroll
    for (int eb = 0; eb < EB; ++eb)
#pragma unroll
      for (int i = 0; i < 16; ++i) { const float v = oacc[0][eb][i] * inv[0] - oacc[NMAP - 1][eb][i] * l1; oacc[0][eb][i] = v; ss += v * v; }
    ss += __shfl_xor(ss, 32);
    const float rr = rsqrtf(ss * (1.0f / 128.0f) + EPS) * a.oscale;
#pragma unroll
    for (int eb = 0; eb < EB; ++eb)
#pragma unroll
      for (int g4 = 0; g4 < 4; ++g4) {
        const int e = eb * 32 + g4 * 8 + 4 * h; const f32x4 g = *(const f32x4*)(a.g0 + e);
        u32x2 w; w[0] = pk2(oacc[0][eb][4 * g4] * rr * g[0], oacc[0][eb][4 * g4 + 1] * rr * g[1]); w[1] = pk2(oacc[0][eb][4 * g4 + 2] * rr * g[2], oacc[0][eb][4 * g4 + 3] * rr * g[3]);
        if (!a.nostore) *(u32x2*)(orow + e) = w;
      }
  } else {
#pragma unroll
    for (int eb = 0; eb < EB; ++eb)
#pragma unroll
      for (int g4 = 0; g4 < 4; ++g4) {
        const int e = eb * 32 + g4 * 8 + 4 * h; const float iv = inv[0];
        u32x2 w; w[0] = pk2(oacc[0][eb][4 * g4] * iv, oacc[0][eb][4 * g4 + 1] * iv); w[1] = pk2(oacc[0][eb][4 * g4 + 2] * iv, oacc[0][eb][4 * g4 + 3] * iv);
        *(u32x2*)(orow + e) = w;
      }
  }
  }
}

DI void xa_unit(unsigned char* smem, const AttnArgs& a, int t0, int head) {
  constexpr int KP = 528;
  const int tid = my_tid(), lane = tid & 63, wid = tid >> 6, r = lane & 31, h = lane >> 5;
  const int tq = t0 + wid * 32 + r;
  const int seq = t0 < TP ? (t0 >> 13) : 8 + ((t0 - TP) >> 11);
  const bf16_t* kbase = a.K + (size_t)(seq * 256) * 1024 + head * 256;
  const bf16_t* vbase = a.VT + (size_t)(seq * 4 + head) * 65536;
  const bf16_t* qrow = a.Q + (size_t)tq * 1024 + head * 256; bf16_t* orow = a.O + (size_t)tq * 1024 + head * 256;
  {
    u32x4 rk[8];
#pragma unroll
    for (int rd = 0; rd < 2; ++rd) {
#pragma unroll
      for (int i = 0; i < 8; ++i) { const int c = tid + NTHR * (8 * rd + i), kk = c >> 5, kc = c & 31; rk[i] = *(const u32x4*)(kbase + (size_t)kk * 1024 + kc * 8); }
#pragma unroll
      for (int i = 0; i < 8; ++i) { const int c = tid + NTHR * (8 * rd + i), kk = c >> 5, kc = c & 31; const int pr = (kk & ~12) | ((kk & 4) << 1) | ((kk & 8) >> 1); *(u32x4*)(smem + pr * KP + kc * 16) = rk[i]; }
    }
  }
  bf16x8 qf[16];
#pragma unroll
  for (int s = 0; s < 16; ++s) qf[s] = *(const bf16x8*)(qrow + 16 * s + 8 * h);
  {
    float ss = 0.f;
#pragma unroll
    for (int s = 0; s < 16; ++s) ss = ssq8(qf[s], ss);
    ss += __shfl_xor(ss, 32);
    const float rr = rsqrtf(ss * (1.0f / 256.0f) + EPS) * 0.0625f * LOG2E;
#pragma unroll
    for (int s = 0; s < 16; ++s) { const u32x4 u = __builtin_bit_cast(u32x4, qf[s]); u32x4 w; const float* g = a.g0 + 16 * s + 8 * h;
#pragma unroll
      for (int j = 0; j < 4; ++j) w[j] = pk2(bflo(u[j]) * rr * g[2 * j], bfhi(u[j]) * rr * g[2 * j + 1]);
      qf[s] = __builtin_bit_cast(bf16x8, w); }
  }
  __syncthreads();
  u32x4 rvv[8];
#define XA_VLOAD(eh_) do { _Pragma("unroll") for (int i = 0; i < 8; ++i) rvv[i] = *(const u32x4*)(vbase + (size_t)(tid + NTHR * (2 * i + (eh_))) * 8); } while (0)
#define XA_VWRITE(eh_) do { _Pragma("unroll") for (int i = 0; i < 8; ++i) { const int c = tid + NTHR * (2 * i + (eh_)), kb = c >> 10, rem = c & 1023, e = rem >> 2, kc = rem & 3; *(u32x4*)(smem + e * KP + kb * 64 + kc * 16) = rvv[i]; } } while (0)
  XA_VLOAD(0);
  __builtin_amdgcn_sched_barrier(0);
  const float negM = -a.M;
  bf16x8 pfr[8][2];
  float lsum = 0.f;
#pragma unroll
  for (int kb = 0; kb < 8; ++kb) {
    f32x16 sacc;
#pragma unroll
    for (int i = 0; i < 16; ++i) sacc[i] = negM;
#pragma unroll
    for (int s = 0; s < 16; ++s) { const bf16x8 kf = *(const bf16x8*)(smem + (kb * 32 + r) * KP + s * 32 + 16 * h); sacc = MFMA(kf, qf[s], sacc); }
    float ls = 0.f;
#pragma unroll
    for (int i = 0; i < 16; ++i) { sacc[i] = __builtin_amdgcn_exp2f(sacc[i]); ls += sacc[i]; }
    lsum += ls;
#pragma unroll
    for (int cc = 0; cc < 2; ++cc) { u32x4 u;
#pragma unroll
      for (int j = 0; j < 4; ++j) u[j] = pk2(sacc[8 * cc + 2 * j], sacc[8 * cc + 2 * j + 1]);
      pfr[kb][cc] = __builtin_bit_cast(bf16x8, u); }
    __builtin_amdgcn_sched_barrier(0);
  }
  lsum += __shfl_xor(lsum, 32);
  const float inv = 1.0f / lsum;
  __syncthreads();
  XA_VWRITE(0);
  XA_VLOAD(1);
  __syncthreads();
#pragma unroll
  for (int eh = 0; eh < 2; ++eh) {
    if (eh == 1) { XA_VWRITE(1); __syncthreads(); }
    f32x16 oacc[4];
#pragma unroll
    for (int e = 0; e < 4; ++e)
#pragma unroll
      for (int i = 0; i < 16; ++i) oacc[e][i] = 0.f;
#pragma unroll
    for (int kb = 0; kb < 8; ++kb)
#pragma unroll
      for (int eb = 0; eb < 4; ++eb)
#pragma unroll
        for (int cc = 0; cc < 2; ++cc) {
          const bf16x8 vf = *(const bf16x8*)(smem + (eh * 128 + eb * 32 + r) * KP + (kb * 32 + 16 * cc + 8 * h) * 2);
          oacc[eb] = MFMA(vf, pfr[kb][cc], oacc[eb]);
        }
#pragma unroll
    for (int eb = 0; eb < 4; ++eb)
#pragma unroll
      for (int g4 = 0; g4 < 4; ++g4) {
        const int e = eh * 128 + eb * 32 + g4 * 8 + 4 * h;
        u32x2 w; w[0] = pk2(oacc[eb][4 * g4] * inv, oacc[eb][4 * g4 + 1] * inv); w[1] = pk2(oacc[eb][4 * g4 + 2] * inv, oacc[eb][4 * g4 + 3] * inv);
        *(u32x2*)(orow + e) = w;
      }
  }
#undef XA_VLOAD
#undef XA_VWRITE
}

template <int KS, int NMAP, int EB, int NKB, int MODE>
DI void attn_phase(unsigned char* smem, const AttnArgs& a, int* ctr) {
  int* s_unit = (int*)(smem + LDS_MAIN);
  constexpr int total = (MODE == AT_XA) ? 1536 : 3072;
  for (;;) {
    __syncthreads();
    if (my_tid() == 0) *s_unit = atomicAdd(ctr, 1);
    __syncthreads();
    const int u = *s_unit;
    if (u >= total) break;
    int head, qb, ehalf = 0;
    if (MODE == AT_XA) { head = u & 3; qb = u >> 2; }
    else { head = 7 - (u / 384); qb = u % 384; }
    if (MODE == AT_XA) xa_unit(smem, a, qb * 256, head);
    else attn_unit<KS, NMAP, EB, NKB, MODE>(smem, a, qb * 256, head, ehalf);
  }
}

DI void conv_fix(KargP p, int layer) {
  bf16_t* act = (bf16_t*)(p->ws + OFF_ACT);
  const bf16_t* gedge = (const bf16_t*)(p->ws + OFF_GEDGE); const bf16_t* uedge = (const bf16_t*)(p->ws + OFF_UEDGE);
  const float* cw = p->in[29] + (size_t)layer * 3 * 2816; const float* cb = p->in[30] + (size_t)layer * 2816;
  const int items = 384 * 2 * 704;
  for (int it = blockIdx.x * NTHR + my_tid(); it < items; it += gridDim.x * NTHR) {
    const int f = (it % 704) * 4, me = it / 704, e = me & 1, mt = me >> 1;
    const int t = mt * 256 + (e ? 255 : 0); int ss0, S; tok_info(t, ss0, S); const int pos = t - ss0;
    const bool has = e ? (pos + 1 < S) : (pos > 0);
    const u32x2 z = {0u, 0u};
    const u32x2 gm = e ? *(const u32x2*)(gedge + (size_t)(mt * 4 + 2) * 2816 + f) : (has ? *(const u32x2*)(gedge + (size_t)((mt - 1) * 4 + 3) * 2816 + f) : z);
    const u32x2 gc = *(const u32x2*)(gedge + (size_t)(mt * 4 + (e ? 3 : 0)) * 2816 + f);
    const u32x2 gp = e ? (has ? *(const u32x2*)(gedge + (size_t)((mt + 1) * 4 + 0) * 2816 + f) : z) : *(const u32x2*)(gedge + (size_t)(mt * 4 + 1) * 2816 + f);
    const f32x4 w0 = *(const f32x4*)(cw + f), w1 = *(const f32x4*)(cw + 2816 + f), w2 = *(const f32x4*)(cw + 5632 + f), bb = *(const f32x4*)(cb + f);
    const u32x2 ub = *(const u32x2*)(uedge + (size_t)me * 2816 + f);
    const f32x4 u = {bflo(ub[0]), bfhi(ub[0]), bflo(ub[1]), bfhi(ub[1])};
    f32x4 v;
    v[0] = w0[0] * bflo(gm[0]) + w1[0] * bflo(gc[0]) + w2[0] * bflo(gp[0]) + bb[0];
    v[1] = w0[1] * bfhi(gm[0]) + w1[1] * bfhi(gc[0]) + w2[1] * bfhi(gp[0]) + bb[1];
    v[2] = w0[2] * bflo(gm[1]) + w1[2] * bflo(gc[1]) + w2[2] * bflo(gp[1]) + bb[2];
    v[3] = w0[3] * bfhi(gm[1]) + w1[3] * bfhi(gc[1]) + w2[3] * bfhi(gp[1]) + bb[3];
    u32x2 w;
    w[0] = pk2(v[0] / (1.f + __expf(-v[0])) * u[0], v[1] / (1.f + __expf(-v[1])) * u[1]);
    w[1] = pk2(v[2] / (1.f + __expf(-v[2])) * u[2], v[3] / (1.f + __expf(-v[3])) * u[3]);
    *(u32x2*)(act + (size_t)t * 2816 + f) = w;
  }
}

DI void run_phase(KargP p, int ph, unsigned char* smem) {
  unsigned char* ws = p->ws;
  bf16_t* R = (bf16_t*)(ws + OFF_R);
  bf16_t* xb = (bf16_t*)(ws + OFF_XB);
  const float* cf = (const float*)(ws + OFF_CONSTS);
  int* ctr = (int*)(ws + OFF_CONSTS + 256);
  const float* rope = (const float*)(ws + OFF_ROPE);
  EpiArgs ea{};
  if (ph == 0) { phase_prep(p, smem); return; }
  if (ph == 1) {
    for (int l = 0; l < 4; ++l) {
      ea.o0 = (bf16_t*)(ws + OFF_MEMK) + (size_t)l * NMEMT * 1024; ea.o1 = (bf16_t*)(ws + OFF_MEMVT) + (size_t)l * NMEMT * 1024;
      gemm_phase<EPI_MEMKV, false>(smem, (const bf16_t*)(ws + OFF_MEMB), 1024, (const bf16_t*)(ws + OFF_W_XA_KV) + (size_t)l * 2048 * 1024, 1024, 0, NMEMT / 256, 8, ea);
    }
  }
  int q = ph - 1, layer = 0;
  for (;;) { const int n = (layer & 1) ? 9 : 10; if (q < n) break; q -= n; ++layer; }
  const int j = layer >> 1;
  const int nm = (layer & 1) ? 3 : 4;
  if (q < nm) {
    if (!(layer & 1)) {
      bf16_t* Qb = R; bf16_t* Kb = R + (size_t)T * 768; bf16_t* VTb = R + (size_t)T * 1536; bf16_t* Cb = R + (size_t)T * 2048; bf16_t* Ob = Cb;
      if (q == 0) {
        ea.o0 = Cb; ea.ldc = 672; ea.nvalid = 672;
        gemm_phase<EPI_PLAIN, true>(smem, xb, 1024, (const bf16_t*)(ws + OFF_W_MLA_DOWN) + (size_t)j * 768 * 1024, 1024, 0, T / 256, 3, ea);
      } else if (q == 1) {
        if (layer == 0) memk_norm(p);
        ea.o0 = Qb; ea.ldc = 768; ea.nvalid = 768;
        gemm_phase<EPI_PLAIN, true>(smem, Cb, 672, (const bf16_t*)(ws + OFF_W_MLA_UQ) + (size_t)j * 768 * 384, 384, 0, T / 256, 3, ea);
        EpiArgs eb{}; eb.o0 = Kb; eb.o1 = VTb; eb.g0 = p->in[11] + j * 96; eb.aux = Cb; eb.rope = rope;
        gemm_phase<EPI_MLAKV, true>(smem, Cb + 384, 672, (const bf16_t*)(ws + OFF_W_MLA_UKV) + (size_t)j * 1024 * 256, 256, 0, T / 256, 4, eb);
      } else if (q == 2) {
        AttnArgs a{}; a.Q = Qb; a.K = Kb; a.VT = VTb; a.O = Ob; a.g0 = p->in[10] + j * 96; a.rope = rope; a.M = cf[j];
        for (int rp = 0; rp < REP_MLA; ++rp) attn_phase<6, 1, 2, 2, AT_MLA>(smem, a, ctr + layer * 2 + 16 * rp);
      } else {
        ea.XB = xb;
        gemm_phase<EPI_RES, false>(smem, Ob, 512, (const bf16_t*)(ws + OFF_W_MLA_WO) + (size_t)j * 1024 * 512, 512, 0, T / 256, 4, ea);
      }
    } else {
      bf16_t* Qb = R; bf16_t* Kb = R + (size_t)T * 1024; bf16_t* VTb = R + (size_t)T * 2048;
      if (q == 0) {
        ea.o0 = Qb; ea.o1 = Kb; ea.o2 = VTb; ea.g0 = p->in[15] + j * 128; ea.g1 = p->in[16] + j * 128;
        gemm_phase<EPI_DIFFQKV, true>(smem, xb, 1024, (const bf16_t*)(ws + OFF_W_DIFF_QKV) + (size_t)j * 3072 * 1024, 1024, 0, T / 256, 12, ea);
      } else if (q == 1) {
        const float linit = 0.8f - 0.6f * expf(-0.3f * (float)layer);
        AttnArgs a{}; a.Q = Qb; a.K = Kb; a.VT = VTb; a.O = Qb; a.g0 = p->in[18] + j * 128; a.M = cf[2 + j]; a.lam = cf[4 + j]; a.oscale = 1.f - linit;
        for (int rp = 0; rp < REP_DIFF; ++rp) { int ns = (rp + 1 < REP_DIFF); asm volatile("" : "+s"(ns)); a.nostore = ns; attn_phase<4, 2, 4, 1, AT_DIFF>(smem, a, ctr + layer * 2 + 16 * rp); }
      } else {
        ea.XB = xb;
        gemm_phase<EPI_RES, false>(smem, Qb, 1024, (const bf16_t*)(ws + OFF_W_DIFF_WO) + (size_t)j * 1024 * 1024, 1024, 0, T / 256, 4, ea);
      }
    }
    return;
  }
  q -= nm;
  if (q < 3) {
    bf16_t* XQ = R; bf16_t* XO = R + (size_t)T * 1024;
    if (q == 0) {
      ea.o0 = XQ; ea.ldc = 1024; ea.nvalid = 1024;
      gemm_phase<EPI_PLAIN, true>(smem, xb, 1024, (const bf16_t*)(ws + OFF_W_XA_Q) + (size_t)layer * 1024 * 1024, 1024, 0, T / 256, 4, ea);
    } else if (q == 1) {
      AttnArgs a{}; a.Q = XQ; a.K = (const bf16_t*)(ws + OFF_MEMK) + (size_t)layer * NMEMT * 1024; a.VT = (const bf16_t*)(ws + OFF_MEMVT) + (size_t)layer * NMEMT * 1024; a.O = XO;
      a.g0 = p->in[24] + layer * 256; a.M = cf[6 + layer];
      for (int rp = 0; rp < REP_XA; ++rp) attn_phase<16, 1, 4, 1, AT_XA>(smem, a, ctr + layer * 2 + 1 + 16 * rp);
    } else {
      ea.XB = xb;
      gemm_phase<EPI_RES, false>(smem, XO, 1024, (const bf16_t*)(ws + OFF_W_XA_O) + (size_t)layer * 1024 * 1024, 1024, 0, T / 256, 4, ea);
    }
    return;
  }
  q -= 3;
  {
    bf16_t* act = (bf16_t*)(ws + OFF_ACT);
    if (q == 0) {
      ea.o0 = act; ea.cw = p->in[29] + (size_t)layer * 3 * 2816; ea.cb = p->in[30] + (size_t)layer * 2816;
      ea.gedge = (bf16_t*)(ws + OFF_GEDGE); ea.uedge = (bf16_t*)(ws + OFF_UEDGE);
      gemm_phase<EPI_GUCONV, true>(smem, xb, 1024, (const bf16_t*)(ws + OFF_W_FFN_GU) + (size_t)layer * 5632 * 1024, 1024, 0, T / 256, 22, ea);
    } else if (q == 1) {
      conv_fix(p, layer);
    } else {
      ea.XB = xb; if (layer == 3) ea.X = p->out;
      gemm_phase<EPI_RES, false>(smem, act, 2816, (const bf16_t*)(ws + OFF_W_FFN_DOWN) + (size_t)layer * 1024 * 2816, 2816, 0, T / 256, 4, ea);
    }
  }
}

DI void grid_barrier(unsigned* xb, unsigned xcc, unsigned n_x, unsigned nxcd, unsigned k) {
  asm volatile("s_waitcnt vmcnt(0)" ::: "memory");
  __syncthreads();
  if (my_tid() == 0) {
    const unsigned old = __hip_atomic_fetch_add(xb + 1024 + 64 * xcc, 1u, __ATOMIC_RELAXED, __HIP_MEMORY_SCOPE_AGENT);
    if (old + 1u == n_x * k) {
      __builtin_amdgcn_fence(__ATOMIC_RELEASE, "agent");
      asm volatile("s_waitcnt vmcnt(0)" ::: "memory");
      __hip_atomic_fetch_add(xb + 2048, 1u, __ATOMIC_RELAXED, __HIP_MEMORY_SCOPE_AGENT);
    }
    while (__hip_atomic_load(xb + 2048, __ATOMIC_RELAXED, __HIP_MEMORY_SCOPE_AGENT) < nxcd * k) __builtin_amdgcn_s_sleep(2);
    __builtin_amdgcn_fence(__ATOMIC_ACQUIRE, "agent");
    asm volatile("s_waitcnt vmcnt(0)" ::: "memory");
  }
  __syncthreads();
}

#if MULTI_LAUNCH
__global__ void __launch_bounds__(NTHR, 2) k_phase(P p, int ph) {
  extern __shared__ __attribute__((aligned(16))) unsigned char smem[];
  run_phase(get_kargs(), ph, smem);
}
#else
__global__ void __launch_bounds__(NTHR, 2) k_mega(P p) {
  extern __shared__ __attribute__((aligned(16))) unsigned char smem[];
  cg::grid_group grid = cg::this_grid();
  unsigned* xbw = (unsigned*)(get_kargs()->ws + OFF_XBAR);
  const unsigned xcc = (unsigned)__builtin_amdgcn_s_getreg((3 << 11) | 20) & 0xFu;
  if (my_tid() == 0) __hip_atomic_fetch_add(xbw + 64 * xcc, 1u, __ATOMIC_RELAXED, __HIP_MEMORY_SCOPE_AGENT);
  phase_prep(get_kargs(), smem);
  grid.sync();
  unsigned n_x = __hip_atomic_load(xbw + 64 * xcc, __ATOMIC_RELAXED, __HIP_MEMORY_SCOPE_AGENT), nxcd = 0;
  for (int j = 0; j < 16; ++j) nxcd += __hip_atomic_load(xbw + 64 * j, __ATOMIC_RELAXED, __HIP_MEMORY_SCOPE_AGENT) != 0u ? 1u : 0u;
  n_x = __builtin_amdgcn_readfirstlane(n_x); nxcd = __builtin_amdgcn_readfirstlane(nxcd);
#pragma nounroll
  for (int ph = 1; ph < NPHASE; ++ph) {
    KargP pp = get_kargs();
    run_phase(pp, ph, smem);
    if (ph + 1 < NPHASE) grid_barrier(xbw, xcc, n_x, nxcd, (unsigned)ph);
  }
}
#endif

extern "C" void kernel_launch(void* const* d_in, const int* in_sizes, int n_in, void* d_out, int out_size, void* d_ws, size_t ws_size, hipStream_t stream) {
  static int grid_blocks = 0;
#if MULTI_LAUNCH
  const void* kfn = (const void*)k_phase;
#else
  const void* kfn = (const void*)k_mega;
#endif
  if (!grid_blocks) {
    if (n_in != 32 || ws_size < WS_NEED) { fprintf(stderr, "kernel_launch: unexpected n_in %d or ws_size %zu (< %zu)\n", n_in, ws_size, (size_t)WS_NEED); grid_blocks = -1; return; }
    int dev = 0, cus = 0, per_cu = 0;
    hipGetDevice(&dev);
    hipDeviceGetAttribute(&cus, hipDeviceAttributeMultiprocessorCount, dev);
    hipFuncSetAttribute(kfn, hipFuncAttributeMaxDynamicSharedMemorySize, LDS_BYTES);
    hipOccupancyMaxActiveBlocksPerMultiprocessor(&per_cu, kfn, NTHR, LDS_BYTES);
    if (per_cu < 1) per_cu = 1;
    if (per_cu > 1) per_cu = 1;
    grid_blocks = cus * per_cu;
    fprintf(stderr, "kernel_launch: grid %d (%d CUs x %d)\n", grid_blocks, cus, per_cu);
  }
  if (grid_blocks < 0) return;
  P hp{};
  for (int i = 0; i < 32; ++i) hp.in[i] = (const float*)d_in[i];
  hp.out = (float*)d_out; hp.ws = (unsigned char*)d_ws;
#if MULTI_LAUNCH
  for (int ph = 0; ph < NPHASE; ++ph) hipLaunchKernelGGL(k_phase, dim3(grid_blocks), dim3(NTHR), LDS_BYTES, stream, hp, ph);
#else
  if (hipMemsetAsync((unsigned char*)d_ws + OFF_XBAR, 0, 16384, stream) != hipSuccess) { fprintf(stderr, "kernel_launch: hipMemsetAsync of the barrier word failed\n"); return; }
  void* args[] = {&hp};
  hipError_t e = hipLaunchCooperativeKernel(kfn, dim3(grid_blocks), dim3(NTHR), args, LDS_BYTES, stream);
  if (e != hipSuccess) fprintf(stderr, "cooperative launch failed: %s (grid %d)\n", hipGetErrorString(e), grid_blocks);
#endif
}
```
